# Optimizing an MI355X kernel written in HIP

```python
import math
import jax, jax.numpy as jnp
from jax import lax
import numpy as np

D_MODEL = 4096
BATCH = 4
SEQ = 2048
DEPTH = 1

HEAD_DIM = 128
N_HEADS_TOTAL = D_MODEL // HEAD_DIM
H_MOBA = N_HEADS_TOTAL // 2
H_DSA = N_HEADS_TOTAL - H_MOBA
W_MOBA = H_MOBA * HEAD_DIM
W_DSA = H_DSA * HEAD_DIM
MOBA_BLOCK = 256
MOBA_TOPK = 3
MOBA_Q_CHUNK = 16
IDX_HEADS = 16
IDX_DIM = 64
DSA_TOPK = 256
DSA_Q_CHUNK = 32
NUM_BUCKETS = 32
MAX_DISTANCE = 128
D_FF = 256 * ((8 * D_MODEL // 3 + 255) // 256)
CONV_WIDTH = 3
ALPHA = (2.0 * DEPTH) ** 0.25
BETA = (8.0 * DEPTH) ** -0.25
NEG = -1e30
LN_EPS = 1e-5

_SIZES = (W_MOBA, W_MOBA, W_MOBA, W_DSA, W_DSA, W_DSA,
          IDX_HEADS * IDX_DIM, IDX_DIM, IDX_HEADS)
IN_COLS = sum(_SIZES)
SPLIT_POINTS = tuple(sum(_SIZES[:i + 1]) for i in range(len(_SIZES) - 1))

kernel_name = "hymba_moba_dsa_deepnorm_layer"


def layer_norm(x, g, b):
    xf = x.astype(jnp.float32)
    mu = jnp.mean(xf, axis=-1, keepdims=True)
    var = jnp.mean(jnp.square(xf - mu), axis=-1, keepdims=True)
    y = (xf - mu) * lax.rsqrt(var + LN_EPS) * g.astype(jnp.float32) + b.astype(jnp.float32)
    return y.astype(x.dtype)


def rms_norm(x, g):
    xf = x.astype(jnp.float32)
    y = xf * lax.rsqrt(jnp.mean(jnp.square(xf), axis=-1, keepdims=True) + LN_EPS)
    return (y * g.astype(jnp.float32)).astype(x.dtype)


def t5_bucket(dist):
    d = jnp.maximum(dist, 0)
    max_exact = NUM_BUCKETS // 2
    df = jnp.maximum(d, max_exact).astype(jnp.float32)
    large = max_exact + (jnp.log(df / max_exact) / math.log(MAX_DISTANCE / max_exact)
                         * (NUM_BUCKETS - max_exact)).astype(jnp.int32)
    large = jnp.minimum(large, NUM_BUCKETS - 1)
    return jnp.where(d < max_exact, d, large)


def rel_bias(dist, tab):
    bucket = t5_bucket(dist)
    h = jnp.arange(tab.shape[0]).reshape((1, -1) + (1,) * (bucket.ndim - 2))
    return tab[h, bucket].astype(jnp.float32)


def chunk_axis(a, axis, size):
    shape = a.shape
    n = shape[axis] // size
    a = a.reshape(shape[:axis] + (n, size) + shape[axis + 1:])
    return jnp.moveaxis(a, axis, 0)


def moba_attention(q, k, v, tab):
    B, H, S, Dh = q.shape
    nb = -(-S // MOBA_BLOCK)
    pad = nb * MOBA_BLOCK - S
    kb = jnp.pad(k, ((0, 0), (0, 0), (0, pad), (0, 0))).reshape(B, H, nb, MOBA_BLOCK, Dh)
    vb = jnp.pad(v, ((0, 0), (0, 0), (0, pad), (0, 0))).reshape(B, H, nb, MOBA_BLOCK, Dh)
    kbar = jnp.mean(kb.astype(jnp.float32), axis=3)
    pos = jnp.arange(S, dtype=jnp.int32)
    qblk = pos // MOBA_BLOCK
    gate = jnp.einsum('bhsd,bhnd->bhsn', q.astype(jnp.float32), kbar)
    past = jnp.arange(nb)[None, :] < qblk[:, None]
    gate = jnp.where(past[None, None], gate, NEG)
    n_sel = min(MOBA_TOPK, nb)
    _, top = lax.top_k(gate, n_sel)
    own = jnp.broadcast_to(qblk, (B, H, S))[..., None]
    sel = jnp.concatenate([top.astype(jnp.int32), own], axis=-1)
    slot_ok = jnp.concatenate([jnp.arange(n_sel)[None, :] < qblk[:, None],
                               jnp.ones((S, 1), dtype=bool)], axis=-1)
    scale = HEAD_DIM ** -0.5
    bi = jnp.arange(B)[:, None, None, None]
    hi = jnp.arange(H)[None, :, None, None]
    offs = jnp.arange(MOBA_BLOCK, dtype=jnp.int32)

    def step(args):
        q_c, sel_c, t_c, ok_c = args
        kg = kb[bi, hi, sel_c]
        vg = vb[bi, hi, sel_c]
        logits = jnp.einsum('bhqd,bhqjkd->bhqjk', q_c, kg).astype(jnp.float32) * scale
        kpos = sel_c[..., None] * MOBA_BLOCK + offs
        dist = t_c[None, None, :, None, None] - kpos
        logits = logits + rel_bias(dist, tab)
        ok = ok_c[None, None, :, :, None] & (dist >= 0)
        logits = jnp.where(ok, logits, NEG)
        shp = logits.shape
        p = jax.nn.softmax(logits.reshape(shp[:3] + (-1,)), axis=-1).reshape(shp)
        return jnp.einsum('bhqjk,bhqjkd->bhqd', p.astype(v.dtype), vg)

    out = lax.map(step, (chunk_axis(q, 2, MOBA_Q_CHUNK), chunk_axis(sel, 2, MOBA_Q_CHUNK),
                         chunk_axis(pos, 0, MOBA_Q_CHUNK), chunk_axis(slot_ok, 0, MOBA_Q_CHUNK)))
    return jnp.moveaxis(out, 0, 2).reshape(B, H, S, Dh)


def dsa_attention(q, k, v, q_idx, k_idx, w_idx, tab):
    B, H, S, Dh = q.shape
    n_top = min(DSA_TOPK, S // 4)
    pos = jnp.arange(S, dtype=jnp.int32)
    scale = HEAD_DIM ** -0.5
    bi = jnp.arange(B)[:, None, None, None]
    hi = jnp.arange(H)[None, :, None, None]

    def step(args):
        q_c, qi_c, wi_c, t_c = args
        s = jnp.einsum('bqhd,bsd->bqsh', qi_c, k_idx).astype(jnp.float32) * IDX_DIM ** -0.5
        w = wi_c.astype(jnp.float32) * IDX_HEADS ** -0.5
        score = jnp.einsum('bqsh,bqh->bqs', jax.nn.relu(s), w)
        admissible = pos[None, :] <= t_c[:, None]
        score = jnp.where(admissible[None], score, NEG)
        _, sel = lax.top_k(score, n_top)
        sel = sel.astype(jnp.int32)
        kg = k[bi, hi, sel[:, None]]
        vg = v[bi, hi, sel[:, None]]
        logits = jnp.einsum('bhqd,bhqkd->bhqk', q_c, kg).astype(jnp.float32) * scale
        dist = (t_c[None, :, None] - sel)[:, None]
        logits = logits + rel_bias(dist, tab)
        logits = jnp.where(dist >= 0, logits, NEG)
        p = jax.nn.softmax(logits, axis=-1)
        return jnp.einsum('bhqk,bhqkd->bhqd', p.astype(v.dtype), vg)

    out = lax.map(step, (chunk_axis(q, 2, DSA_Q_CHUNK), chunk_axis(q_idx, 1, DSA_Q_CHUNK),
                         chunk_axis(w_idx, 1, DSA_Q_CHUNK), chunk_axis(pos, 0, DSA_Q_CHUNK)))
    return jnp.moveaxis(out, 0, 2).reshape(B, H, S, Dh)


def setup_inputs(seed: int = 0) -> dict:
    key = jax.random.key(seed)
    ks = jax.random.split(key, 16)
    f32 = jnp.float32
    x = jax.random.normal(ks[0], (BATCH, SEQ, D_MODEL), f32)
    col_scale = jnp.concatenate([
        jnp.ones((2 * W_MOBA,), f32), jnp.full((W_MOBA,), BETA, f32),
        jnp.ones((2 * W_DSA,), f32), jnp.full((W_DSA,), BETA, f32),
        jnp.ones((IDX_HEADS * IDX_DIM + IDX_DIM + IDX_HEADS,), f32)])
    w_in = jax.random.normal(ks[1], (D_MODEL, IN_COLS), f32) * D_MODEL ** -0.5 * col_scale
    rel_table = 0.5 * jax.random.normal(ks[2], (NUM_BUCKETS, N_HEADS_TOTAL), f32)
    g_moba = 1.0 + 0.01 * jax.random.normal(ks[3], (W_MOBA,), f32)
    g_dsa = 1.0 + 0.01 * jax.random.normal(ks[4], (W_DSA,), f32)
    w_out = jax.random.normal(ks[5], (D_MODEL, D_MODEL), f32) * D_MODEL ** -0.5 * BETA
    ln1_g = 1.0 + 0.01 * jax.random.normal(ks[6], (D_MODEL,), f32)
    ln1_b = 0.01 * jax.random.normal(ks[7], (D_MODEL,), f32)
    w_up = jax.random.normal(ks[8], (D_MODEL, 2 * D_FF), f32) * D_MODEL ** -0.5 * BETA
    conv_w = jax.random.normal(ks[9], (CONV_WIDTH, 2 * D_FF), f32) * CONV_WIDTH ** -0.5
    conv_b = 0.01 * jax.random.normal(ks[10], (2 * D_FF,), f32)
    w_down = jax.random.normal(ks[11], (D_FF, D_MODEL), f32) * D_FF ** -0.5 * BETA
    ln2_g = 1.0 + 0.01 * jax.random.normal(ks[12], (D_MODEL,), f32)
    ln2_b = 0.01 * jax.random.normal(ks[13], (D_MODEL,), f32)
    return {"x": x, "w_in": w_in, "rel_table": rel_table, "g_moba": g_moba,
            "g_dsa": g_dsa, "w_out": w_out, "ln1_g": ln1_g, "ln1_b": ln1_b,
            "w_up": w_up, "conv_w": conv_w, "conv_b": conv_b, "w_down": w_down,
            "ln2_g": ln2_g, "ln2_b": ln2_b}


def reference(x, w_in, rel_table, g_moba, g_dsa, w_out, ln1_g, ln1_b,
              w_up, conv_w, conv_b, w_down, ln2_g, ln2_b):
    B, S, _ = x.shape

    def heads(t, n):
        return t.reshape(B, S, n, HEAD_DIM).transpose(0, 2, 1, 3)

    def merge(t):
        return t.transpose(0, 2, 1, 3).reshape(B, S, -1)

    for _layer in range(DEPTH):
        proj = x @ w_in
        q_a, k_a, v_a, q_b, k_b, v_b, qi, ki, wi = jnp.split(proj, SPLIT_POINTS, axis=-1)
        y_a = moba_attention(heads(q_a, H_MOBA), heads(k_a, H_MOBA), heads(v_a, H_MOBA),
                             rel_table[:, :H_MOBA].T)
        y_b = dsa_attention(heads(q_b, H_DSA), heads(k_b, H_DSA), heads(v_b, H_DSA),
                            qi.reshape(B, S, IDX_HEADS, IDX_DIM), ki, wi,
                            rel_table[:, H_MOBA:].T)
        mixed = jnp.concatenate([rms_norm(merge(y_a), g_moba),
                                 rms_norm(merge(y_b), g_dsa)], axis=-1) @ w_out
        x = layer_norm(ALPHA * x + mixed, ln1_g, ln1_b)

        u = x @ w_up
        up = jnp.pad(u, ((0, 0), (CONV_WIDTH - 1, 0), (0, 0)))
        u = sum(conv_w[j] * up[:, j:j + S] for j in range(CONV_WIDTH)) + conv_b
        val, gate = jnp.split(u, 2, axis=-1)
        ffn = (val * jax.nn.silu(gate)) @ w_down
        x = layer_norm(ALPHA * x + ffn, ln2_g, ln2_b)
    return x
```

```cpp
#include <hip/hip_runtime.h>
#include <cstdio>
#include <cstdint>
namespace pg8 {
#define PG8_LAS __attribute__((address_space(3)))
typedef unsigned short bf16_t;
typedef _Float16 bf16x8 __attribute__((ext_vector_type(8)));
typedef float f32x4 __attribute__((ext_vector_type(4)));
typedef unsigned u32x4 __attribute__((ext_vector_type(4)));
constexpr int BM = 256, BK = 64, HALF = 128, HTB = HALF * BK * 2  , STAGE_BYTES = 8 * HTB, NXCD = 8, WGM = 8;

__host__ __device__ __forceinline__ int lds_byte(int r, int c) { const int st = (r >> 4) * 2 + (c >> 5), rr = r & 15, cc = c & 31, ob = rr * 64 + cc * 2; return st * 1024 + (ob ^ (((ob >> 9) & 1) << 5)); }
__host__ __device__ __forceinline__ void stage_rc(int b, int& R, int& C) { const int st = b / 1024, sb = b % 1024, swz = sb ^ (((sb >> 9) & 1) << 5); R = (st >> 1) * 16 + swz / 64; C = (st & 1) * 32 + (swz % 64) / 2; }
__host__ __device__ __forceinline__ int perm32(int rho) { const int n = rho >> 4, i = rho & 15; return 8 * (i >> 2) + 4 * n + (i & 3); }

struct Unit { int pm, pn; };
struct Gemm { const bf16_t* A; const bf16_t* Bt; int M, N, K; };

struct StaticOrder {
    int nM, nN, nwg, G, c;
    __host__ __device__ void init(int M, int N, int G_, int c_) { nM = M / BM; nN = N / BM; nwg = nM * nN; G = G_; c = c_; }
    __host__ __device__ bool next(int i, Unit& u) const {
        const long L = (long)i * G + c; if (L >= nwg) return false;
        int wgid = (int)L; { const int q = nwg / NXCD, r = nwg % NXCD, xcd = wgid % NXCD, off = wgid / NXCD; wgid = (xcd < r ? xcd * (q + 1) : r * (q + 1) + (xcd - r) * q) + off; }
        const int nig = WGM * nN, gid = wgid / nig, fm = gid * WGM, gsz = (nM - fm) < WGM ? (nM - fm) : WGM;
        u.pm = fm + ((wgid % nig) % gsz); u.pn = (wgid % nig) / gsz; return true;
    }
    __device__ __forceinline__ void a_ready(const Unit&) const {}
    __device__ __forceinline__ void done(const Unit&) const {}
};

__device__ __forceinline__ unsigned cvt_pk_f16(float lo, float hi) { typedef float f2v __attribute__((ext_vector_type(2))); typedef _Float16 h2v __attribute__((ext_vector_type(2)));
    return __builtin_bit_cast(unsigned, __builtin_convertvector((f2v){lo, hi}, h2v)); }
struct EpiF16 {
    static constexpr bool PERM = true, AFTER_DRAIN = false, HAS_MID = false;
    bf16_t* O; int ldc; float scale; int t0, t1, b0, b1, b2;
    float* kbar; int kt0, kt1;
    __device__ __forceinline__ void operator()(const f32x4 (&acc)[2][2][4][2], const Unit& u, int wr, int wc, int fr, int fq) const {
        const int colt = u.pn < t0 ? b0 + u.pn * BM : (u.pn < t1 ? b1 + (u.pn - t0) * BM : b2 + (u.pn - t1) * BM);
        const int row0 = u.pm * BM + wr * 64 + fr, col0 = colt + wc * 32 + 8 * fq;
        if (kbar && u.pn >= kt0 && u.pn < kt1) {
#pragma unroll
            for (int bj = 0; bj < 2; ++bj)
#pragma unroll
                for (int n = 0; n < 2; ++n) { f32x4 sm = acc[0][bj][0][n];
#pragma unroll
                    for (int ai = 0; ai < 2; ++ai)
#pragma unroll
                        for (int m = 0; m < 4; ++m) if (ai | m) sm += acc[ai][bj][m][n];
#pragma unroll
                    for (int j = 0; j < 4; ++j) { float v = sm[j];
                        v += __uint_as_float((unsigned)__builtin_amdgcn_update_dpp(0, (int)__float_as_uint(v), 0x111, 0xF, 0xF, true));
                        v += __uint_as_float((unsigned)__builtin_amdgcn_update_dpp(0, (int)__float_as_uint(v), 0x112, 0xF, 0xF, true));
                        v += __uint_as_float((unsigned)__builtin_amdgcn_update_dpp(0, (int)__float_as_uint(v), 0x114, 0xF, 0xF, true));
                        v += __uint_as_float((unsigned)__builtin_amdgcn_update_dpp(0, (int)__float_as_uint(v), 0x118, 0xF, 0xF, true));
                        if (fr == 15) { const int hh = 2 * (u.pn - kt0) + bj, d = wc * 32 + 8 * fq + 4 * n + j;
                            atomicAdd(kbar + ((size_t)(((u.pm >> 3) * 16 + hh) * 8 + (u.pm & 7))) * 128 + d, v * scale * (1.f / 256.f)); } } }
        }
#pragma unroll
        for (int ai = 0; ai < 2; ++ai)
#pragma unroll
            for (int m = 0; m < 4; ++m) { bf16_t* rowp = O + (size_t)(row0 + ai * HALF + m * 16) * ldc + col0;
#pragma unroll
                for (int bj = 0; bj < 2; ++bj) { const f32x4 v0 = acc[ai][bj][m][0] * scale, v1 = acc[ai][bj][m][1] * scale;
                    u32x4 w; w.x = cvt_pk_f16(v0[0], v0[1]); w.y = cvt_pk_f16(v0[2], v0[3]); w.z = cvt_pk_f16(v1[0], v1[1]); w.w = cvt_pk_f16(v1[2], v1[3]);
                    *(u32x4*)(rowp + bj * HALF) = w; } }
    }
};
struct EpiQ8 {
    static constexpr bool PERM = true, AFTER_DRAIN = false, HAS_MID = false;
    unsigned char* O; int ldc; float scale;
    __device__ __forceinline__ static unsigned pk4(f32x4 v) {
        const float a = __builtin_fminf(__builtin_fmaxf(v[0], -240.f), 240.f), b = __builtin_fminf(__builtin_fmaxf(v[1], -240.f), 240.f), c = __builtin_fminf(__builtin_fmaxf(v[2], -240.f), 240.f), d = __builtin_fminf(__builtin_fmaxf(v[3], -240.f), 240.f);
        int w = __builtin_amdgcn_cvt_pk_fp8_f32(a, b, 0, false); w = __builtin_amdgcn_cvt_pk_fp8_f32(c, d, w, true); return (unsigned)w; }
    __device__ __forceinline__ void operator()(const f32x4 (&acc)[2][2][4][2], const Unit& u, int wr, int wc, int fr, int fq) const {
        typedef unsigned u32x2 __attribute__((ext_vector_type(2)));
        const int row0 = u.pm * BM + wr * 64 + fr, col0 = u.pn * BM + wc * 32 + 8 * fq;
#pragma unroll
        for (int ai = 0; ai < 2; ++ai)
#pragma unroll
            for (int m = 0; m < 4; ++m) { unsigned char* rowp = O + (size_t)(row0 + ai * HALF + m * 16) * ldc + col0;
#pragma unroll
                for (int bj = 0; bj < 2; ++bj) { u32x2 w; w.x = pk4(acc[ai][bj][m][0] * scale); w.y = pk4(acc[ai][bj][m][1] * scale); *(u32x2*)(rowp + bj * HALF) = w; } }
    }
};
struct EpiConvGate {
    static constexpr bool PERM = true, AFTER_DRAIN = false, HAS_MID = false, PERMA = true;
    unsigned char* H; int ldh;
    float* HB;
    const float* cw; const float* cb;
    int dff; float dsc, sch;
    PG8_LAS unsigned char* xl;
    typedef float f2v __attribute__((ext_vector_type(2)));
    template <int CTRL> __device__ __forceinline__ static float dppf(float old, float src) { return __uint_as_float((unsigned)__builtin_amdgcn_update_dpp((int)__float_as_uint(old), (int)__float_as_uint(src), CTRL, 0xF, 0xF, false)); }
    __device__ __forceinline__ void operator()(const f32x4 (&acc)[2][2][4][2], const Unit& u, int wr, int wc, int fr, int fq) const {
        PG8_LAS float* X = (PG8_LAS float*)xl; PG8_LAS f32x4* TP = (PG8_LAS f32x4*)(xl + 16384);
        const int tid = ((wr * 4 + wc) << 6) + fq * 16 + fr, hc0 = 32 * wc + 8 * fq;
        if (tid < 256) { const int sgn = tid >> 7, hc = tid & 127; const size_t ch = (size_t)sgn * dff + (size_t)u.pn * 128 + hc;
            const float f = sgn ? 1.4426950408889634f : sch * 0.6931471805599453f, fd = f * dsc;
            PG8_LAS float* T = (PG8_LAS float*)TP + (sgn * 64 + (hc >> 1)) * 8 + (hc & 1);
            T[0] = cw[ch] * fd; T[2] = cw[2 * (size_t)dff + ch] * fd; T[4] = cw[4 * (size_t)dff + ch] * fd; T[6] = cb[ch] * f; }
        if (fr == 15) {
#pragma unroll
            for (int ai = 0; ai < 2; ++ai) { PG8_LAS f32x4* d = (PG8_LAS f32x4*)(X + ((((ai * 2 + wr) * 4 + wc) * 4 + fq) * 2) * 16);
#pragma unroll
                for (int k = 0; k < 2; ++k) { d[k * 4 + 0] = acc[ai][0][2 + k][0]; d[k * 4 + 1] = acc[ai][0][2 + k][1]; d[k * 4 + 2] = acc[ai][1][2 + k][0]; d[k * 4 + 3] = acc[ai][1][2 + k][1]; } } }
        { const bool first = (wr == 0 && fr == 0), last = (wr == 1 && fr == 15);
          if (first || last) {
#pragma unroll
              for (int k = 0; k < 2; ++k) { float* hb = HB + ((size_t)u.pm * 4 + (first ? k : 2 + k)) * (2 * (size_t)dff) + (size_t)u.pn * 128 + hc0;
#pragma unroll
                  for (int sgn = 0; sgn < 2; ++sgn)
#pragma unroll
                      for (int n = 0; n < 2; ++n) *(f32x4*)(hb + (size_t)sgn * dff + 4 * n) = (first ? acc[0][sgn][k][n] : acc[1][sgn][2 + k][n]) * dsc; } } }
        asm volatile("s_waitcnt lgkmcnt(0)" ::: "memory"); __builtin_amdgcn_s_barrier(); asm volatile("" ::: "memory");
#pragma unroll
        for (int ai = 0; ai < 2; ++ai) {
            f32x4 t14[2][2], t15[2][2];
            const bool hasprev = (wr == 1) || (ai == 1);
            if (hasprev) { const int pai = (wr == 1) ? ai : 0, pwr = (wr == 1) ? 0 : 1; const PG8_LAS f32x4* sp = (const PG8_LAS f32x4*)(X + ((((pai * 2 + pwr) * 4 + wc) * 4 + fq) * 2) * 16);
                t14[0][0] = sp[0]; t14[0][1] = sp[1]; t14[1][0] = sp[2]; t14[1][1] = sp[3]; t15[0][0] = sp[4]; t15[0][1] = sp[5]; t15[1][0] = sp[6]; t15[1][1] = sp[7]; }
            else {
#pragma unroll
                for (int a = 0; a < 2; ++a)
#pragma unroll
                    for (int b = 0; b < 2; ++b) { t14[a][b] = (f32x4){0.f, 0.f, 0.f, 0.f}; t15[a][b] = (f32x4){0.f, 0.f, 0.f, 0.f}; } }
            unsigned w[4] = {0u, 0u, 0u, 0u};
#pragma unroll
            for (int n = 0; n < 2; ++n) {
                int hcx = hc0 >> 1; asm volatile("" : "+v"(hcx));
                f2v cv[2][4][2];
#pragma unroll
                for (int sgn = 0; sgn < 2; ++sgn)
#pragma unroll
                    for (int jp = 0; jp < 2; ++jp) { const int j = 2 * jp;
                        const f2v x0 = {acc[ai][sgn][0][n][j], acc[ai][sgn][0][n][j + 1]}, x1 = {acc[ai][sgn][1][n][j], acc[ai][sgn][1][n][j + 1]},
                                  x2 = {acc[ai][sgn][2][n][j], acc[ai][sgn][2][n][j + 1]}, x3 = {acc[ai][sgn][3][n][j], acc[ai][sgn][3][n][j + 1]};
                        const f2v p3 = {dppf<0x111>(t15[sgn][n][j], x3.x), dppf<0x111>(t15[sgn][n][j + 1], x3.y)},
                                  p2 = {dppf<0x111>(t14[sgn][n][j], x2.x), dppf<0x111>(t14[sgn][n][j + 1], x2.y)};
                        const f32x4 ta = TP[(sgn * 64 + hcx + n * 2 + jp) * 2], tb = TP[(sgn * 64 + hcx + n * 2 + jp) * 2 + 1];
                        const f2v w0 = {ta.x, ta.y}, w1 = {ta.z, ta.w}, w2 = {tb.x, tb.y}, bb = {tb.z, tb.w};
                        cv[sgn][0][jp] = w0 * p2 + (w1 * p3 + (w2 * x0 + bb));
                        cv[sgn][1][jp] = w0 * p3 + (w1 * x0 + (w2 * x1 + bb));
                        cv[sgn][2][jp] = w0 * x0 + (w1 * x1 + (w2 * x2 + bb));
                        cv[sgn][3][jp] = w0 * x1 + (w1 * x2 + (w2 * x3 + bb)); }
#pragma unroll
                for (int m = 0; m < 4; ++m)
#pragma unroll
                    for (int jp = 0; jp < 2; ++jp) { const f2v g = cv[1][m][jp]; const f2v d = (f2v){__builtin_amdgcn_exp2f(-g.x), __builtin_amdgcn_exp2f(-g.y)} + (f2v){1.f, 1.f};
                        const f2v hv = cv[0][m][jp] * g * (f2v){__builtin_amdgcn_rcpf(d.x), __builtin_amdgcn_rcpf(d.y)};
                        if (n == 0) { if (jp == 0) w[m] = __builtin_amdgcn_cvt_scalef32_pk_fp4_f32(w[m], hv.x, hv.y, 1.0f, 0); else w[m] = __builtin_amdgcn_cvt_scalef32_pk_fp4_f32(w[m], hv.x, hv.y, 1.0f, 1); }
                        else { if (jp == 0) w[m] = __builtin_amdgcn_cvt_scalef32_pk_fp4_f32(w[m], hv.x, hv.y, 1.0f, 2); else w[m] = __builtin_amdgcn_cvt_scalef32_pk_fp4_f32(w[m], hv.x, hv.y, 1.0f, 3); } }
            }
#pragma unroll
            for (int m = 0; m < 4; ++m) { const int row = u.pm * BM + ai * HALF + wr * 64 + 4 * fr + m;
                *(unsigned*)(H + (size_t)row * ldh + ((size_t)u.pn * 128 + hc0) / 2) = w[m]; }
        }
    }
};
struct EpiResF32 {
    static constexpr bool PERM = false, AFTER_DRAIN = false, HAS_MID = false;
    float* C; const float* R; int ldc; float alpha, ascale;
    __device__ __forceinline__ void operator()(const f32x4 (&acc)[2][2][4][2], const Unit& u, int wr, int wc, int fr, int fq) const {
        const int row0 = u.pm * BM + wr * 64 + fr, col0 = u.pn * BM + wc * 32 + 4 * fq;
#pragma unroll
        for (int ai = 0; ai < 2; ++ai)
#pragma unroll
            for (int m = 0; m < 4; ++m) { const size_t off = (size_t)(row0 + ai * HALF + m * 16) * ldc + col0;
                f32x4 rv[2][2];
#pragma unroll
                for (int bj = 0; bj < 2; ++bj)
#pragma unroll
                    for (int n = 0; n < 2; ++n) rv[bj][n] = *(const f32x4*)(R + off + bj * HALF + n * 16);
#pragma unroll
                for (int bj = 0; bj < 2; ++bj)
#pragma unroll
                    for (int n = 0; n < 2; ++n) *(f32x4*)(C + off + bj * HALF + n * 16) = rv[bj][n] * alpha + acc[ai][bj][m][n] * ascale;
                asm volatile("" ::: "memory"); }
    }
};

typedef _Float16 h4v __attribute__((ext_vector_type(4)));
__device__ __forceinline__ f32x4 h4_to_f32(unsigned lo, unsigned hi) { typedef unsigned u2v __attribute__((ext_vector_type(2))); const h4v h = __builtin_bit_cast(h4v, (u2v){lo, hi}); return (f32x4){(float)h[0], (float)h[1], (float)h[2], (float)h[3]}; }
struct EpiResH {
    static constexpr bool PERM = true, AFTER_DRAIN = false, HAS_MID = false;
    bf16_t* Z; const float* R; int ldc; float alpha, ascale;
    __device__ __forceinline__ void operator()(const f32x4 (&acc)[2][2][4][2], const Unit& u, int wr, int wc, int fr, int fq) const {
        const int row0 = u.pm * BM + wr * 64 + fr, col0 = u.pn * BM + wc * 32 + 8 * fq;
#pragma unroll
        for (int ai = 0; ai < 2; ++ai)
#pragma unroll
            for (int m = 0; m < 4; ++m) { const size_t off = (size_t)(row0 + ai * HALF + m * 16) * ldc + col0;
                f32x4 rv[2][2];
#pragma unroll
                for (int bj = 0; bj < 2; ++bj)
#pragma unroll
                    for (int n = 0; n < 2; ++n) rv[bj][n] = *(const f32x4*)(R + off + bj * HALF + n * 4);
#pragma unroll
                for (int bj = 0; bj < 2; ++bj) { const f32x4 v0 = rv[bj][0] * alpha + acc[ai][bj][m][0] * ascale, v1 = rv[bj][1] * alpha + acc[ai][bj][m][1] * ascale;
                    u32x4 w; w.x = cvt_pk_f16(v0[0], v0[1]); w.y = cvt_pk_f16(v0[2], v0[3]); w.z = cvt_pk_f16(v1[0], v1[1]); w.w = cvt_pk_f16(v1[2], v1[3]);
                    *(u32x4*)(Z + off + bj * HALF) = w; }
                asm volatile("" ::: "memory"); }
    }
};
struct EpiResHRms {
    static constexpr bool PERM = true, AFTER_DRAIN = false, HAS_MID = true;
    bf16_t* Z; const bf16_t* Rh; const float* ssq; int ldc; float alpha, ascale, inv_w, eps;
    __device__ __forceinline__ void mid(f32x4 (&acc)[2][2][4][2], const Unit& u, int wr, int fr) const {
        typedef float f32x2 __attribute__((ext_vector_type(2)));
#pragma unroll
        for (int ai = 0; ai < 2; ++ai)
#pragma unroll
            for (int m = 0; m < 4; ++m) { const int row = u.pm * BM + ai * HALF + wr * 64 + m * 16 + fr; const f32x2 q = *(const f32x2*)(ssq + 2 * (size_t)row);
                const float ratio = __builtin_sqrtf((q.y * inv_w + eps) / (q.x * inv_w + eps));
#pragma unroll
                for (int bj = 0; bj < 2; ++bj)
#pragma unroll
                    for (int n = 0; n < 2; ++n) acc[ai][bj][m][n] = acc[ai][bj][m][n] * ratio; }
    }
    __device__ __forceinline__ void operator()(const f32x4 (&acc)[2][2][4][2], const Unit& u, int wr, int wc, int fr, int fq) const {
        const int row0 = u.pm * BM + wr * 64 + fr, col0 = u.pn * BM + wc * 32 + 8 * fq;
#pragma unroll
        for (int ai = 0; ai < 2; ++ai) {
            u32x4 rv[4][2]; float sq[4];
#pragma unroll
            for (int m = 0; m < 4; ++m) { const int row = row0 + ai * HALF + m * 16; const size_t off = (size_t)row * ldc + col0;
                sq[m] = ssq[2 * (size_t)row + 1];
#pragma unroll
                for (int bj = 0; bj < 2; ++bj) rv[m][bj] = *(const u32x4*)(Rh + off + bj * HALF); }
#pragma unroll
            for (int m = 0; m < 4; ++m) { const int row = row0 + ai * HALF + m * 16; const size_t off = (size_t)row * ldc + col0;
                const float rb = ascale / __builtin_sqrtf(sq[m] * inv_w + eps);
#pragma unroll
                for (int bj = 0; bj < 2; ++bj) { const f32x4 r0 = h4_to_f32(rv[m][bj].x, rv[m][bj].y), r1 = h4_to_f32(rv[m][bj].z, rv[m][bj].w);
                    const f32x4 v0 = r0 * alpha + acc[ai][bj][m][0] * rb, v1 = r1 * alpha + acc[ai][bj][m][1] * rb;
                    u32x4 w; w.x = cvt_pk_f16(v0[0], v0[1]); w.y = cvt_pk_f16(v0[2], v0[3]); w.z = cvt_pk_f16(v1[0], v1[1]); w.w = cvt_pk_f16(v1[2], v1[3]);
                    *(u32x4*)(Z + off + bj * HALF) = w; } }
            asm volatile("" ::: "memory"); }
    }
};
struct EpiLnResH {
    static constexpr bool PERM = true, AFTER_DRAIN = false, HAS_MID = false;
    bf16_t* Z; const float* stats; const float* g; const float* b; int ldc; float alpha, ascale;
    __device__ __forceinline__ void operator()(const f32x4 (&acc)[2][2][4][2], const Unit& u, int wr, int wc, int fr, int fq) const {
        typedef float f32x2 __attribute__((ext_vector_type(2)));
        const int row0 = u.pm * BM + wr * 64 + fr, col0 = u.pn * BM + wc * 32 + 8 * fq;
        f32x4 gv[2][2], bv[2][2];
#pragma unroll
        for (int bj = 0; bj < 2; ++bj)
#pragma unroll
            for (int n = 0; n < 2; ++n) { gv[bj][n] = *(const f32x4*)(g + col0 + bj * HALF + n * 4); bv[bj][n] = *(const f32x4*)(b + col0 + bj * HALF + n * 4); }
#pragma unroll
        for (int ai = 0; ai < 2; ++ai) {
            u32x4 zv[4][2]; f32x2 stv[4];
#pragma unroll
            for (int m = 0; m < 4; ++m) { const int row = row0 + ai * HALF + m * 16; const size_t off = (size_t)row * ldc + col0;
                stv[m] = *(const f32x2*)(stats + 2 * (size_t)row);
#pragma unroll
                for (int bj = 0; bj < 2; ++bj) zv[m][bj] = *(const u32x4*)(Z + off + bj * HALF); }
#pragma unroll
            for (int m = 0; m < 4; ++m) { const int row = row0 + ai * HALF + m * 16; const size_t off = (size_t)row * ldc + col0; const f32x2 st = stv[m];
#pragma unroll
                for (int bj = 0; bj < 2; ++bj) { const f32x4 z0 = h4_to_f32(zv[m][bj].x, zv[m][bj].y), z1 = h4_to_f32(zv[m][bj].z, zv[m][bj].w);
                    const f32x4 v0 = ((z0 - st.x) * st.y * gv[bj][0] + bv[bj][0]) * alpha + acc[ai][bj][m][0] * ascale, v1 = ((z1 - st.x) * st.y * gv[bj][1] + bv[bj][1]) * alpha + acc[ai][bj][m][1] * ascale;
                    u32x4 w; w.x = cvt_pk_f16(v0[0], v0[1]); w.y = cvt_pk_f16(v0[2], v0[3]); w.z = cvt_pk_f16(v1[0], v1[1]); w.w = cvt_pk_f16(v1[2], v1[3]);
                    *(u32x4*)(Z + off + bj * HALF) = w; } }
            asm volatile("" ::: "memory"); }
    }
};
struct EpiLnResF32 {
    static constexpr bool PERM = false, AFTER_DRAIN = false, HAS_MID = false;
    float* C; const float* R; const float* stats; const float* g; const float* b; int ldc; float alpha, ascale;
    __device__ __forceinline__ void operator()(const f32x4 (&acc)[2][2][4][2], const Unit& u, int wr, int wc, int fr, int fq) const {
        typedef float f32x2 __attribute__((ext_vector_type(2)));
        const int row0 = u.pm * BM + wr * 64 + fr, col0 = u.pn * BM + wc * 32 + 4 * fq;
        f32x4 gv[2][2], bv[2][2];
#pragma unroll
        for (int bj = 0; bj < 2; ++bj)
#pragma unroll
            for (int n = 0; n < 2; ++n) { gv[bj][n] = *(const f32x4*)(g + col0 + bj * HALF + n * 16); bv[bj][n] = *(const f32x4*)(b + col0 + bj * HALF + n * 16); }
#pragma unroll
        for (int ai = 0; ai < 2; ++ai)
#pragma unroll
            for (int m = 0; m < 4; ++m) { const int row = row0 + ai * HALF + m * 16; const size_t off = (size_t)row * ldc + col0;
                const f32x2 st = *(const f32x2*)(stats + 2 * (size_t)row);
                f32x4 rv[2][2];
#pragma unroll
                for (int bj = 0; bj < 2; ++bj)
#pragma unroll
                    for (int n = 0; n < 2; ++n) rv[bj][n] = *(const f32x4*)(R + off + bj * HALF + n * 16);
#pragma unroll
                for (int bj = 0; bj < 2; ++bj)
#pragma unroll
                    for (int n = 0; n < 2; ++n) *(f32x4*)(C + off + bj * HALF + n * 16) = ((rv[bj][n] - st.x) * st.y * gv[bj][n] + bv[bj][n]) * alpha + acc[ai][bj][m][n] * ascale;
                asm volatile("" ::: "memory"); }
    }
};
typedef int i32x4 __attribute__((ext_vector_type(4)));
typedef int i32x8 __attribute__((ext_vector_type(8)));
template <int FMT> struct Frag;
template <> struct Frag<16> { bf16x8 k[2]; };
template <> struct Frag<8> { i32x8 v; };
template <> struct Frag<4> { i32x4 k[2]; };
template <int FMT> __device__ __forceinline__ void frag_load(Frag<FMT>& f, const PG8_LAS unsigned char* p) {
    if constexpr (FMT == 16) { f.k[0] = *(const PG8_LAS bf16x8*)p; f.k[1] = *(const PG8_LAS bf16x8*)(p + 1024); }
    else if constexpr (FMT == 8) { const i32x4 lo = *(const PG8_LAS i32x4*)p, hi = *(const PG8_LAS i32x4*)(p + 1024); f.v = __builtin_shufflevector(lo, hi, 0, 1, 2, 3, 4, 5, 6, 7); }
    else { f.k[0] = *(const PG8_LAS i32x4*)p; f.k[1] = *(const PG8_LAS i32x4*)(p + 1024); }
}
template <int FMT> __device__ __forceinline__ f32x4 frag_mma(const Frag<FMT>& b, const Frag<FMT>& a, f32x4 c, int p) {
    if constexpr (FMT == 16) { return __builtin_amdgcn_mfma_f32_16x16x32_f16(b.k[p], a.k[p], c, 0, 0, 0); }
    else {
#if defined(__HIP_DEVICE_COMPILE__)
        if constexpr (FMT == 8) asm volatile("v_mfma_f32_16x16x128_f8f6f4 %0, %1, %2, %0" : "+v"(c) : "v"(b.v), "v"(a.v));
        else asm volatile("v_mfma_f32_16x16x128_f8f6f4 %0, %1, %2, %0 cbsz:4 blgp:4" : "+v"(c) : "v"(b.k[p]), "v"(a.k[p]));
#endif
        return c; }
}
template <class E, class = void> struct PermA { static constexpr bool v = false; };
template <class E> struct PermA<E, decltype((void)E::PERMA)> { static constexpr bool v = E::PERMA; };
template <class Epi, class Sched, bool ALIGN_EPI = false, bool SP2 = false, int FMT = 16, bool BAL = false>
__device__ __forceinline__ void gemm_phase(PG8_LAS unsigned char* lds, const Gemm g, const Sched& S, const Epi& E) {
    const int tid = threadIdx.x, wid = __builtin_amdgcn_readfirstlane(tid >> 6), lane = tid & 63, wr = wid >> 2, wc = wid & 3, fr = lane & 15, fq = lane >> 4;
    const int K = g.K, RB = K / 8 * FMT, nt = RB / 128;
    unsigned voffA[2], voffB[2];
#pragma unroll
    for (int i = 0; i < 2; ++i) { int R, C; stage_rc(tid * 16 + i * 8192, R, C); const int Rb = Epi::PERM ? ((R & ~31) + perm32(R & 31)) : R;
        const int Ra = PermA<Epi>::v ? ((R & ~63) + 4 * (R & 15) + ((R >> 4) & 3)) : R;
        voffA[i] = (unsigned)(Ra * RB + C * 2); voffB[i] = (unsigned)(Rb * RB + C * 2); }
    const size_t kstep = (size_t)(BK * 2);
    const size_t hstep = (size_t)HALF * RB;
    const size_t tstep = 2 * hstep;
    const unsigned ldsw = (unsigned)wid * 1024u;
    const int aoff = lds_byte(wr * 64 + fr, fq * 8), boff = lds_byte(wc * 32 + fr, fq * 8);
#define PG8_SA(b, h) (((b) * 2 + (h)) * HTB)
#define PG8_SB(b, h) ((4 + (b) * 2 + (h)) * HTB)
#define PG8_STAGE(bufoff, gbase, voff) do { _Pragma("unroll") for (int _i = 0; _i < 2; ++_i) \
        __builtin_amdgcn_global_load_lds((const unsigned*)((const char*)(gbase) + (voff)[_i]), (PG8_LAS unsigned*)(lds + (bufoff) + ldsw + _i * 8192), 16, 0, 0); } while (0)
#define PG8_LDA(dst, b, h) do { _Pragma("unroll") for (int m = 0; m < 4; ++m) frag_load<FMT>(dst[m], lds + PG8_SA(b, h) + aoff + m * 2048); } while (0)
#define PG8_LDB(dst, b, h) do { _Pragma("unroll") for (int n = 0; n < 2; ++n) frag_load<FMT>(dst[n], lds + PG8_SB(b, h) + boff + n * 2048); } while (0)
#define PG8_MMA(ai, bj, At, Bt) do { __builtin_amdgcn_s_setprio(1); \
        if constexpr (FMT == 16) { _Pragma("unroll") for (int m = 0; m < 4; ++m) _Pragma("unroll") for (int n = 0; n < 2; ++n) _Pragma("unroll") for (int k = 0; k < 2; ++k) \
            acc[ai][bj][m][n] = frag_mma<FMT>(Bt[n], At[m], acc[ai][bj][m][n], k); } \
        else { _Pragma("unroll") for (int k = 0; k < (FMT == 4 ? 2 : 1); ++k) _Pragma("unroll") for (int m = 0; m < 4; ++m) _Pragma("unroll") for (int n = 0; n < 2; ++n)     \
            acc[ai][bj][m][n] = frag_mma<FMT>(Bt[n], At[m], acc[ai][bj][m][n], k); } \
        __builtin_amdgcn_s_setprio(0); } while (0)
#define PG8_WAIT_V(n) asm volatile("s_waitcnt vmcnt(" #n ")" ::: "memory")
#define PG8_WAIT_L(n) asm volatile("s_waitcnt lgkmcnt(" #n ")" ::: "memory")
#define PG8_BAR __builtin_amdgcn_s_barrier()
#define PG8_SCHED __builtin_amdgcn_sched_barrier(0)
    Unit cur, nxt; int ui = 0;
    if (!S.next(0, cur)) return;
    f32x4 acc[2][2][4][2];
#pragma unroll
    for (int a = 0; a < 2; ++a)
#pragma unroll
        for (int b = 0; b < 2; ++b)
#pragma unroll
            for (int m = 0; m < 4; ++m)
#pragma unroll
                for (int n = 0; n < 2; ++n) acc[a][b][m][n] = (f32x4){0.f, 0.f, 0.f, 0.f};
    Frag<FMT> At[4], B0[2], B1[2];
    const char* cA = (const char*)g.A + (size_t)cur.pm * tstep; const char* cB = (const char*)g.Bt + (size_t)cur.pn * tstep;
    S.a_ready(cur);
    if constexpr (SP2 && BAL) {
        PG8_STAGE(PG8_SB(0, 0), cB, voffB); PG8_STAGE(PG8_SB(0, 1), cB + hstep, voffB); PG8_STAGE(PG8_SA(0, 0), cA, voffA); PG8_STAGE(PG8_SA(0, 1), cA + hstep, voffA);
        if (wr == 1) PG8_BAR;
        PG8_WAIT_V(2); PG8_BAR;
        PG8_STAGE(PG8_SB(1, 0), cB + kstep, voffB); PG8_STAGE(PG8_SB(1, 1), cB + hstep + kstep, voffB);
        PG8_WAIT_V(4); PG8_BAR;
    } else if constexpr (SP2) {
        PG8_STAGE(PG8_SB(0, 0), cB, voffB); PG8_STAGE(PG8_SB(0, 1), cB + hstep, voffB); PG8_STAGE(PG8_SA(0, 0), cA, voffA); PG8_STAGE(PG8_SA(0, 1), cA + hstep, voffA);
        if (wr == 1) PG8_BAR;
        PG8_WAIT_V(2); PG8_BAR;
        PG8_STAGE(PG8_SB(1, 0), cB + kstep, voffB); PG8_STAGE(PG8_SA(1, 0), cA + kstep, voffA); PG8_STAGE(PG8_SB(1, 1), cB + hstep + kstep, voffB);
        PG8_WAIT_V(6); PG8_BAR;
    } else {
        PG8_STAGE(PG8_SB(0, 0), cB, voffB); PG8_STAGE(PG8_SA(0, 0), cA, voffA); PG8_STAGE(PG8_SB(0, 1), cB + hstep, voffB); PG8_STAGE(PG8_SA(0, 1), cA + hstep, voffA);
        if (wr == 1) PG8_BAR;
        PG8_WAIT_V(4); PG8_BAR;
        PG8_STAGE(PG8_SB(1, 0), cB + kstep, voffB); PG8_STAGE(PG8_SA(1, 0), cA + kstep, voffA); PG8_STAGE(PG8_SB(1, 1), cB + hstep + kstep, voffB);
        PG8_WAIT_V(6); PG8_BAR;
    }
    for (;;) {
        const bool has_next = S.next(ui + 1, nxt);
        const char* nA = has_next ? (const char*)g.A + (size_t)nxt.pm * tstep : cA; const char* nB = has_next ? (const char*)g.Bt + (size_t)nxt.pn * tstep : cB;
        for (int t = 0; t < nt; t += 2) {
            if constexpr (Epi::HAS_MID) { if (t == (nt >> 1)) { if constexpr (FMT != 16) asm volatile("s_nop 15\n\ts_nop 15" ::: "memory"); E.mid(acc, cur, wr, fr); } }
            const bool last = (t == nt - 2);
            const char* a1 = cA + (size_t)(t + 1) * kstep;
            const char* a2 = last ? nA : cA + (size_t)(t + 2) * kstep; const char* b2 = last ? nB : cB + (size_t)(t + 2) * kstep;
            const char* a3 = a2 + kstep; const char* b3 = b2 + kstep;
            if (last && has_next) S.a_ready(nxt);
            if constexpr (SP2 && BAL) {
            PG8_LDB(B0, 0, 0); PG8_LDB(B1, 0, 1); PG8_SCHED; PG8_LDA(At, 0, 0); PG8_STAGE(PG8_SA(1, 0), a1, voffA); PG8_STAGE(PG8_SA(1, 1), a1 + hstep, voffA);
            PG8_WAIT_V(8); PG8_WAIT_L(0); PG8_BAR; PG8_MMA(0, 0, At, B0); PG8_MMA(0, 1, At, B1); PG8_BAR; PG8_SCHED;
            PG8_LDA(At, 0, 1); PG8_STAGE(PG8_SB(0, 0), b2, voffB); PG8_STAGE(PG8_SB(0, 1), b2 + hstep, voffB);
            PG8_WAIT_V(6); PG8_WAIT_L(0); PG8_BAR; PG8_MMA(1, 0, At, B0); PG8_MMA(1, 1, At, B1); PG8_BAR; PG8_SCHED;
            PG8_LDB(B0, 1, 0); PG8_LDB(B1, 1, 1); PG8_SCHED; PG8_LDA(At, 1, 0); PG8_STAGE(PG8_SA(0, 0), a2, voffA); PG8_STAGE(PG8_SA(0, 1), a2 + hstep, voffA);
            PG8_WAIT_V(8); PG8_WAIT_L(0); PG8_BAR; PG8_MMA(0, 0, At, B0); PG8_MMA(0, 1, At, B1); PG8_BAR; PG8_SCHED;
            PG8_LDA(At, 1, 1); PG8_STAGE(PG8_SB(1, 0), b3, voffB); PG8_STAGE(PG8_SB(1, 1), b3 + hstep, voffB);
            PG8_WAIT_V(6); PG8_WAIT_L(0); PG8_BAR; PG8_MMA(1, 0, At, B0); PG8_MMA(1, 1, At, B1); PG8_BAR; PG8_SCHED;
            (void)a3;
            } else if constexpr (SP2) {
            PG8_LDB(B0, 0, 0); PG8_LDB(B1, 0, 1); PG8_SCHED; PG8_LDA(At, 0, 0); PG8_STAGE(PG8_SA(1, 1), a1 + hstep, voffA);
            PG8_WAIT_V(8); PG8_WAIT_L(0); PG8_BAR; PG8_MMA(0, 0, At, B0); PG8_MMA(0, 1, At, B1); PG8_BAR; PG8_SCHED;
            PG8_LDA(At, 0, 1); PG8_STAGE(PG8_SB(0, 0), b2, voffB); PG8_STAGE(PG8_SB(0, 1), b2 + hstep, voffB); PG8_STAGE(PG8_SA(0, 0), a2, voffA);
            PG8_WAIT_V(8); PG8_WAIT_L(0); PG8_BAR; PG8_MMA(1, 0, At, B0); PG8_MMA(1, 1, At, B1); PG8_BAR; PG8_SCHED;
            PG8_LDB(B0, 1, 0); PG8_LDB(B1, 1, 1); PG8_SCHED; PG8_LDA(At, 1, 0); PG8_STAGE(PG8_SA(0, 1), a2 + hstep, voffA);
            PG8_WAIT_V(8); PG8_WAIT_L(0); PG8_BAR; PG8_MMA(0, 0, At, B0); PG8_MMA(0, 1, At, B1); PG8_BAR; PG8_SCHED;
            PG8_LDA(At, 1, 1); PG8_STAGE(PG8_SB(1, 0), b3, voffB); PG8_STAGE(PG8_SB(1, 1), b3 + hstep, voffB); PG8_STAGE(PG8_SA(1, 0), a3, voffA);
            PG8_WAIT_V(8); PG8_WAIT_L(0); PG8_BAR; PG8_MMA(1, 0, At, B0); PG8_MMA(1, 1, At, B1); PG8_BAR; PG8_SCHED;
            } else {
            PG8_LDB(B0, 0, 0); PG8_SCHED; PG8_LDA(At, 0, 0); PG8_STAGE(PG8_SA(1, 1), a1 + hstep, voffA);
            PG8_WAIT_L(8); PG8_BAR; PG8_WAIT_L(0); PG8_MMA(0, 0, At, B0); PG8_BAR; PG8_SCHED;
            PG8_LDB(B1, 0, 1); PG8_STAGE(PG8_SB(0, 0), b2, voffB);
            PG8_BAR; PG8_WAIT_L(0); PG8_MMA(0, 1, At, B1); PG8_BAR;
            PG8_LDA(At, 0, 1); PG8_STAGE(PG8_SA(0, 0), a2, voffA);
            PG8_BAR; PG8_WAIT_L(0); PG8_MMA(1, 0, At, B0); PG8_BAR; PG8_SCHED;
            PG8_STAGE(PG8_SB(0, 1), b2 + hstep, voffB);
            PG8_WAIT_V(6); PG8_BAR; PG8_MMA(1, 1, At, B1); PG8_BAR;
            PG8_LDB(B0, 1, 0); PG8_SCHED; PG8_LDA(At, 1, 0); PG8_STAGE(PG8_SA(0, 1), a2 + hstep, voffA);
            PG8_WAIT_L(8); PG8_BAR; PG8_WAIT_L(0); PG8_MMA(0, 0, At, B0); PG8_BAR; PG8_SCHED;
            PG8_LDB(B1, 1, 1); PG8_STAGE(PG8_SB(1, 0), b3, voffB);
            PG8_BAR; PG8_WAIT_L(0); PG8_MMA(0, 1, At, B1); PG8_BAR;
            PG8_LDA(At, 1, 1); PG8_STAGE(PG8_SA(1, 0), a3, voffA);
            PG8_BAR; PG8_WAIT_L(0); PG8_MMA(1, 0, At, B0); PG8_BAR; PG8_SCHED;
            PG8_STAGE(PG8_SB(1, 1), b3 + hstep, voffB);
            PG8_WAIT_V(6); PG8_BAR; PG8_MMA(1, 1, At, B1); PG8_BAR;
            }
        }
        if constexpr (FMT != 16) asm volatile("s_nop 15\n\ts_nop 15" ::: "memory");
        if constexpr (ALIGN_EPI) { if (wr == 0) PG8_BAR; }
        if constexpr (!Epi::AFTER_DRAIN) { E(acc, cur, wr, wc, fr, fq); S.done(cur); }
        if (!has_next) break;
#pragma unroll
        for (int a = 0; a < 2; ++a)
#pragma unroll
            for (int b = 0; b < 2; ++b)
#pragma unroll
                for (int m = 0; m < 4; ++m)
#pragma unroll
                    for (int n = 0; n < 2; ++n) acc[a][b][m][n] = (f32x4){0.f, 0.f, 0.f, 0.f};
        cur = nxt; cA = nA; cB = nB; ++ui;
        if constexpr (ALIGN_EPI) { if (wr == 1) PG8_BAR; }
    }
    PG8_WAIT_V(0);
    if constexpr (!ALIGN_EPI) { if (wr == 0) PG8_BAR; }
    PG8_BAR;
    if constexpr (Epi::AFTER_DRAIN) { E.fused(acc, cur, wr, wc, fr, fq, lds, wid, lane); S.done(cur); }
#undef PG8_SA
#undef PG8_SB
#undef PG8_STAGE
#undef PG8_LDA
#undef PG8_LDB
#undef PG8_MMA
#undef PG8_WAIT_V
#undef PG8_WAIT_L
#undef PG8_BAR
#undef PG8_SCHED
}
}

namespace att {
#define ATT_LAS __attribute__((address_space(3)))
constexpr int D = 128, NW = 8, QBLK = 32, KVBLK = 64, QB = NW * QBLK;
constexpr int LQ = 13568;
constexpr int LO = 4096;
constexpr int SHM_V = KVBLK * D * 2, SHM_K = KVBLK * D * 2;
constexpr int TAB_OFF = 2 * SHM_V + 2 * SHM_K + NW * 64 * 4;
constexpr int MSK_OFF = TAB_OFF + 2048, MSK_LD = 264;
constexpr int ATT_LDS_BYTES = MSK_OFF + 256 * MSK_LD;
constexpr float SCALE = 0.08838834764831845f;
constexpr float THR = 8.f;
typedef _Float16 f16;
typedef _Float16 h8 __attribute__((ext_vector_type(8)));
typedef short s16x4 __attribute__((ext_vector_type(4)));
typedef short s16x8 __attribute__((ext_vector_type(8)));
typedef float f32x16 __attribute__((ext_vector_type(16)));
typedef float f32x4 __attribute__((ext_vector_type(4)));
typedef unsigned u32x4 __attribute__((ext_vector_type(4)));

#define KSWZ(row, colB) ((row) * 256 + ((colB) ^ (((row) & 7) << 4)))
#define SBAR() __builtin_amdgcn_sched_barrier(0)
__device__ __forceinline__ int v_st(int k, int c) { const int kk = (k & ~0xC) | ((k & 4) << 1) | ((k & 8) >> 1); return ((kk >> 3) * 4 + (c >> 5)) * 512 + ((kk & 7) * 32 + (c & 31)) * 2; }
__device__ __forceinline__ int v_rd_base(int lane) { return ((lane & 3) << 3) | (((lane >> 2) & 3) << 6) | (((lane >> 4) & 1) << 5) | (((lane >> 5) & 1) << 8); }
constexpr int v_rd_off(int d0, int ks, int half) { return d0 * 512 + ks * 4096 + half * 2048; }
constexpr float SC_Y8 = 64.f;
__device__ __forceinline__ unsigned pk4_fp8(float a, float b, float c, float d) {
    a = __builtin_fminf(__builtin_fmaxf(a, -240.f), 240.f); b = __builtin_fminf(__builtin_fmaxf(b, -240.f), 240.f); c = __builtin_fminf(__builtin_fmaxf(c, -240.f), 240.f); d = __builtin_fminf(__builtin_fmaxf(d, -240.f), 240.f);
    int w = __builtin_amdgcn_cvt_pk_fp8_f32(a, b, 0, false); w = __builtin_amdgcn_cvt_pk_fp8_f32(c, d, w, true); return (unsigned)w; }
__device__ __forceinline__ int fresh_tid() { int t = threadIdx.x; asm volatile("" : "+v"(t)); return t; }
__device__ __forceinline__ int crow(int r, int hi) { return (r & 3) + 8 * (r >> 2) + 4 * hi; }
__device__ __forceinline__ unsigned cvtpk(float lo, float hi) { return pg8::cvt_pk_f16(lo, hi); }
__device__ __forceinline__ h8 load8(const f16* p) { return *reinterpret_cast<const h8*>(p); }
__device__ __forceinline__ float sel_or_ninf(float p, int keep  ) { return __uint_as_float((__float_as_uint(p) & (unsigned)keep) | (0xff800000u & ~(unsigned)keep)); }
__device__ __forceinline__ void mask_tile(f32x16& p0, f32x16& p1, int dq) {
    const float NEG = -__builtin_inff();
#pragma unroll
    for (int r = 0; r < 16; ++r) {
        const int c = (r & 3) + 8 * (r >> 2);
        if (dq - c < 0) p0[r] = NEG;
        if (dq - c - 32 < 0) p1[r] = NEG;
    }
}
__device__ __forceinline__ void dsa_mask(f32x16& p0, f32x16& p1, unsigned long long w, int hi) {
    const int lo = (int)(unsigned)(w >> (4 * hi)), hw = (int)(unsigned)(w >> (32 + 4 * hi));
#pragma unroll
    for (int r = 0; r < 16; ++r) {
        const int c = (r & 3) + 8 * (r >> 2);
        p0[r] = sel_or_ninf(p0[r], __builtin_amdgcn_sbfe(lo, c, 1));
        p1[r] = sel_or_ninf(p1[r], __builtin_amdgcn_sbfe(hw, c, 1));
    }
}
__device__ __forceinline__ void row_mask(f32x16& p0, f32x16& p1, int keep) {
#pragma unroll
    for (int r = 0; r < 16; ++r) { p0[r] = sel_or_ninf(p0[r], keep); p1[r] = sel_or_ninf(p1[r], keep); }
}
__device__ __forceinline__ void bias_tile(f32x16& p0, f32x16& p1, const ATT_LAS float* tp) {
#pragma unroll
    for (int g = 0; g < 4; ++g) {
        SBAR();
#pragma unroll
        for (int r = 4 * g; r < 4 * g + 4; ++r) {
            const int c = (r & 3) + 8 * (r >> 2);
            p0[r] += tp[60 - c];
            p1[r] += tp[28 - c];
        }
    }
    SBAR();
}
__device__ __forceinline__ void partialSM(f32x16& p0, f32x16& p1, float& m_reg, float& mn, float& alpha) {
    float pmax = p0[0]; for (int r = 1; r < 16; ++r) pmax = fmaxf(pmax, p0[r]); for (int r = 0; r < 16; ++r) pmax = fmaxf(pmax, p1[r]);
    { auto rr = __builtin_amdgcn_permlane32_swap(__float_as_uint(pmax), __float_as_uint(pmax), false, false);
      pmax = fmaxf(__uint_as_float(rr[0]), __uint_as_float(rr[1])); }
    constexpr float C2 = 1.4426950408889634f * SCALE;
    if (__builtin_expect(__all((pmax - m_reg) * SCALE <= THR), 1)) { mn = m_reg; alpha = 1.f; }
    else { mn = fmaxf(m_reg, pmax); alpha = __builtin_amdgcn_exp2f((m_reg - mn) * C2); m_reg = mn; }
    const float mnL = -mn * C2;
    for (int r = 0; r < 16; ++r) p0[r] = fmaf(p0[r], C2, mnL); for (int r = 0; r < 16; ++r) p1[r] = fmaf(p1[r], C2, mnL);
    for (int r = 0; r < 16; ++r) p0[r] = __builtin_amdgcn_exp2f(p0[r]);
}
__device__ __forceinline__ void finishSM(f32x16& p0, f32x16& p1, float alpha, float& l_reg, h8& pa0, h8& pa1, h8& pa2, h8& pa3) {
    for (int r = 0; r < 16; ++r) p1[r] = __builtin_amdgcn_exp2f(p1[r]);
    float ps = 0; for (int r = 0; r < 16; ++r) ps += p0[r]; for (int r = 0; r < 16; ++r) ps += p1[r];
    { auto rr = __builtin_amdgcn_permlane32_swap(__float_as_uint(ps), __float_as_uint(ps), false, false);
      ps = __uint_as_float(rr[0]) + __uint_as_float(rr[1]); }
    l_reg = l_reg * alpha + ps;
#define PK4(P, B_, OUT) do { unsigned a0 = cvtpk(P[B_+0], P[B_+1]), a1 = cvtpk(P[B_+2], P[B_+3]);                          \
        unsigned b0 = cvtpk(P[B_+4], P[B_+5]), b1 = cvtpk(P[B_+6], P[B_+7]);                                             \
        auto r0 = __builtin_amdgcn_permlane32_swap(a0, b0, false, false); auto r1 = __builtin_amdgcn_permlane32_swap(a1, b1, false, false); \
        u32x4 w = {r0[0], r1[0], r0[1], r1[1]}; OUT = __builtin_bit_cast(h8, w); } while (0)
    PK4(p0, 0, pa0); PK4(p0, 8, pa1); PK4(p1, 0, pa2); PK4(p1, 8, pa3);
#undef PK4
}
template <int KB>
__device__ __forceinline__ void qkt(f32x16& p0, f32x16& p1, const char* K_lds, int r32, int hi, const h8* qr) {
    p0 = f32x16{}; p1 = f32x16{};
    const char* kb[4];
#pragma unroll
    for (int dd = 0; dd < 4; ++dd) kb[dd] = K_lds + KB * SHM_K + KSWZ(r32, (dd * 16 + hi * 8) * 2);
#pragma unroll
    for (int d0 = 0; d0 < 8; ++d0) { const char* a = kb[d0 & 3] + (d0 >> 2) * 128;
        h8 b0 = *reinterpret_cast<const h8*>(a);
        h8 b1 = *reinterpret_cast<const h8*>(a + 32 * 256);
        p0 = __builtin_amdgcn_mfma_f32_32x32x16_f16(b0, qr[d0], p0, 0, 0, 0);
        p1 = __builtin_amdgcn_mfma_f32_32x32x16_f16(b1, qr[d0], p1, 0, 0, 0); }
}
template <int VB>
__device__ __forceinline__ void pv_tile(f32x16* o, int vb0, h8 pa0, h8 pa1, h8 pa2, h8 pa3) {
#define TRRD(dst, off) asm volatile("ds_read_b64_tr_b16 %0, %1 offset:%2" : "=&v"(dst) : "v"(vb0), "i"(off) : "memory")
#define HV8(l, h) __builtin_bit_cast(h8, (s16x8){l[0], l[1], l[2], l[3], h[0], h[1], h[2], h[3]})
#define PV_D0(d0) do { s16x4 l0, l1, l2, l3, h0, h1, h2, h3; constexpr int b_ = VB * SHM_V + v_rd_off(d0, 0, 0);     \
        TRRD(l0, b_); TRRD(h0, b_ + 2048); TRRD(l1, b_ + 4096); TRRD(h1, b_ + 6144); TRRD(l2, b_ + 8192); TRRD(h2, b_ + 10240); TRRD(l3, b_ + 12288); TRRD(h3, b_ + 14336); \
        asm volatile("s_waitcnt lgkmcnt(0)" ::: "memory"); SBAR();                 \
        o[d0] = __builtin_amdgcn_mfma_f32_32x32x16_f16(pa0, HV8(l0, h0), o[d0], 0, 0, 0);   \
        o[d0] = __builtin_amdgcn_mfma_f32_32x32x16_f16(pa1, HV8(l1, h1), o[d0], 0, 0, 0);   \
        o[d0] = __builtin_amdgcn_mfma_f32_32x32x16_f16(pa2, HV8(l2, h2), o[d0], 0, 0, 0);   \
        o[d0] = __builtin_amdgcn_mfma_f32_32x32x16_f16(pa3, HV8(l3, h3), o[d0], 0, 0, 0); } while (0)
    PV_D0(0); PV_D0(1); PV_D0(2); PV_D0(3);
#undef PV_D0
#undef HV8
#undef TRRD
}

struct Blk { unsigned Q, K, V; unsigned char* O; float* SQ; const float* G; const unsigned long long* MW; const unsigned char* M8; int P0; int dsa; };
typedef __amdgpu_buffer_rsrc_t rsrc_t;
__device__ __forceinline__ h8 bload8(rsrc_t r, unsigned voff, unsigned soff) { return __builtin_bit_cast(h8, __builtin_amdgcn_raw_buffer_load_b128(r, (int)voff, (int)soff, 0)); }
struct Seam { h8 qr[8]; h8 st_v0, st_v1, st_k0, st_k1; };
#define VMW() asm volatile("s_waitcnt vmcnt(0)" ::: "memory")
#define VMWN(n) asm volatile("s_waitcnt vmcnt(%0)" :: "i"(n) : "memory")
#define SLOAD_H(Kp, Vp, k0) do { const unsigned kp_ = (Kp) + (unsigned)(k0) * (LQ * 2), vp_ = (Vp) + (unsigned)(k0) * (LQ * 2);     \
                         S.st_v0 = bload8(RS, offA, vp_); S.st_v1 = bload8(RS, offB, vp_); S.st_k0 = bload8(RS, offA, kp_); S.st_k1 = bload8(RS, offB, kp_); } while (0)
#define SWRITE_HK(bf) do { *(h8*)(K_lds + (bf) * SHM_K + kws) = S.st_k0; *(h8*)(K_lds + (bf) * SHM_K + kws + 32 * 256) = S.st_k1; } while (0)
#define SWRITE_HV(bf) do { *(h8*)(V_lds + (bf) * SHM_V + vst0) = S.st_v0; *(h8*)(V_lds + (bf) * SHM_V + vst1) = S.st_v1; } while (0)
#define SWRITE_H(bf) do { SWRITE_HV(bf); SWRITE_HK(bf); } while (0)
__device__ __forceinline__ void attn_prime(const Blk& cur, rsrc_t RS, char* lds, Seam& S) {
    const int tid = threadIdx.x, wid = __builtin_amdgcn_readfirstlane(tid >> 6), lane = tid & 63, r32 = lane & 31, hi = lane >> 5;
    const int sr = tid >> 4, sc = (tid & 15) * 8, kws = KSWZ(sr, sc * 2); char* K_lds = lds + 2 * SHM_V;
    const unsigned offA = (unsigned)(sr * LQ + sc) * 2u, offB = offA + 64u * LQ, offQ = (unsigned)(r32 * LQ + hi * 8) * 2u;
    { const unsigned qb_ = cur.Q + (unsigned)(wid * QBLK) * (LQ * 2);
#pragma unroll
      for (int d0 = 0; d0 < 8; ++d0) S.qr[d0] = bload8(RS, offQ + d0 * 32, qb_); }
    SLOAD_H(cur.K, cur.V, 0); VMW(); SWRITE_HK(0);
    __syncthreads();
}
__device__ __forceinline__ void attn_block(const Blk& cur, const Blk& nxt, rsrc_t RS, char* lds, Seam& S) {
    const int tid = fresh_tid(), wid = __builtin_amdgcn_readfirstlane(tid >> 6), lane = tid & 63, r32 = lane & 31, hi = lane >> 5;
    const int NT = (cur.P0 + QB) / KVBLK;
    const int qlo = cur.P0 + wid * QBLK, qm = qlo + r32 - 4 * hi;
    char* V_lds = lds; char* K_lds = lds + 2 * SHM_V;
    float* ws = (float*)(lds + 2 * SHM_V + 2 * SHM_K) + wid * 64; float* li_l = ws, * al_l = ws + 32;
    const ATT_LAS float* tab0 = (const ATT_LAS float*)((ATT_LAS char*)lds + TAB_OFF) + 256 - 60;
    float m_reg = -1e30f, l_reg = 0; f32x16 o[4] = {};
    const int sr = tid >> 4, sc = (tid & 15) * 8, vst0 = v_st(sr, sc), vst1 = v_st(32 + sr, sc), kws = KSWZ(sr, sc * 2);
    const unsigned offA = (unsigned)(sr * LQ + sc) * 2u, offB = offA + 64u * LQ;
    const int vb0 = (int)(uintptr_t)V_lds + v_rd_base(lane);
    const unsigned Kh = cur.K, Vh = cur.V;
    const int dsa = cur.dsa;
    if (dsa) {
        const int ft = fresh_tid();
        const u32x4* src = (const u32x4*)(cur.MW + (size_t)(ft >> 1) * 32 + (ft & 1) * 16); u32x4 mv[8];
#pragma unroll
        for (int j = 0; j < 8; ++j) mv[j] = src[j];
        ATT_LAS unsigned long long* dst = (ATT_LAS unsigned long long*)((ATT_LAS char*)lds + MSK_OFF + (ft >> 1) * MSK_LD + (ft & 1) * 128);
#pragma unroll
        for (int j = 0; j < 8; ++j) { dst[2 * j] = ((unsigned long long)mv[j].y << 32) | mv[j].x; dst[2 * j + 1] = ((unsigned long long)mv[j].w << 32) | mv[j].z; }
        __syncthreads();
    }
    const ATT_LAS unsigned long long* mrow = (const ATT_LAS unsigned long long*)((ATT_LAS char*)lds + MSK_OFF + (wid * QBLK + r32) * MSK_LD);
    const int m8 = (int)cur.M8[wid * QBLK + r32];
#define RESC(a) do { if (__any((a) < 1.f)) { if (hi == 0) al_l[r32] = (a); asm volatile("s_waitcnt lgkmcnt(0)" ::: "memory");              \
                     for (int d_ = 0; d_ < 4; ++d_) for (int r = 0; r < 16; ++r) o[d_][r] *= al_l[crow(r, hi)]; } } while (0)
#define KBASE(t) ((t) * KVBLK)
#define MASKT(P0_, P1_, t) do { const int kb_ = KBASE(t);                                                                  \
        if (kb_ + KVBLK - 1 + 113 > qlo) bias_tile(P0_, P1_, tab0 + (qm - kb_));                                                  \
        if (dsa) dsa_mask(P0_, P1_, mrow[(t)], hi);                                                                                     \
        else if (kb_ < cur.P0) { const int keep_ = -((m8 >> (kb_ >> 8)) & 1); if (!__all(keep_ != 0)) row_mask(P0_, P1_, keep_); } \
        else if (kb_ + KVBLK - 1 > qlo) mask_tile(P0_, P1_, qm - kb_); } while (0)
#define SEAM_K0() do { VMWN(8); SWRITE_HK(0); SBAR(); } while (0)
    f32x16 pA0, pA1, pB0, pB1; float mnA, mnB, alA, alB; h8 pa0, pa1, pa2, pa3;
    SWRITE_HV(0); SBAR();
    if (NT > 1) { SLOAD_H(Kh, Vh, KBASE(1)); }
    SBAR(); qkt<0>(pA0, pA1, K_lds, r32, hi, S.qr);
    MASKT(pA0, pA1, 0); partialSM(pA0, pA1, m_reg, mnA, alA);
    if (NT > 1) { VMW(); SWRITE_H(1); }
    __syncthreads();
#define HALF_STEP(PX0, PX1, mnX, alX, PY0, PY1, alY, t, KB, VB, SB) do {                                                 \
        SBAR(); finishSM(PY0, PY1, alY, l_reg, pa0, pa1, pa2, pa3); SBAR();     \
        qkt<KB>(PX0, PX1, K_lds, r32, hi, S.qr); SBAR();                                                                      \
        if ((t) + 1 < NT) { SLOAD_H(Kh, Vh, KBASE((t) + 1)); SBAR(); }                                                         \
        pv_tile<VB>(o, vb0, pa0, pa1, pa2, pa3); MASKT(PX0, PX1, (t)); partialSM(PX0, PX1, m_reg, mnX, alX);              \
        __syncthreads();                                                                                                      \
        if ((t) + 1 < NT) { VMW(); SWRITE_H(SB); }                                                                             \
        RESC(alX); __syncthreads(); } while (0)
    for (int t = 1; t + 1 < NT; t += 2) {
        HALF_STEP(pB0, pB1, mnB, alB, pA0, pA1, alA, t, 1, 0, 0);
        HALF_STEP(pA0, pA1, mnA, alA, pB0, pB1, alB, t + 1, 0, 1, 1);
    }
    const bool even = (NT & 1) == 0;
    SBAR(); finishSM(pA0, pA1, alA, l_reg, pa0, pa1, pa2, pa3); SBAR();
    if (even) { qkt<1>(pB0, pB1, K_lds, r32, hi, S.qr); SBAR(); }
    { SLOAD_H(nxt.K, nxt.V, 0); SBAR(); const int ft = fresh_tid(); const unsigned qb_ = nxt.Q + (unsigned)(__builtin_amdgcn_readfirstlane(ft >> 6) * QBLK) * (LQ * 2);
      const unsigned offQ = (unsigned)((ft & 31) * LQ + ((ft >> 5) & 1) * 8) * 2u;
#pragma unroll
      for (int d0 = 0; d0 < 8; ++d0) S.qr[d0] = bload8(RS, offQ + d0 * 32, qb_); }
    SBAR();
    pv_tile<0>(o, vb0, pa0, pa1, pa2, pa3);
    if (even) { MASKT(pB0, pB1, NT - 1); partialSM(pB0, pB1, m_reg, mnB, alB); __syncthreads(); RESC(alB);
        finishSM(pB0, pB1, alB, l_reg, pa0, pa1, pa2, pa3); SBAR(); pv_tile<1>(o, vb0, pa0, pa1, pa2, pa3); }
    SBAR(); SEAM_K0();
    { const int ft = fresh_tid(), r32e = ft & 31, hie = (ft >> 5) & 1, wide = __builtin_amdgcn_readfirstlane(ft >> 6);
      float* li_e = (float*)(lds + 2 * SHM_V + 2 * SHM_K) + wide * 64;
      if (hie == 0) li_e[r32e] = l_reg; asm volatile("s_waitcnt lgkmcnt(0)" ::: "memory");
      float rli[16];
#pragma unroll
      for (int r = 0; r < 16; ++r) rli[r] = __builtin_amdgcn_rcpf(li_e[crow(r, hie)]);
      unsigned char* Ow = cur.O + (size_t)(wide * QBLK) * LO; float* sq = cur.SQ + 2 * (wide * QBLK);
      float gq[4];
#pragma unroll
      for (int d0 = 0; d0 < 4; ++d0) gq[d0] = cur.G[d0 * 32 + r32e] * SC_Y8;
#pragma unroll
      for (int r = 0; r < 16; ++r) { const int orow = crow(r, hie); float ss = 0.f;
#pragma unroll
        for (int d0 = 0; d0 < 4; ++d0) { const float v = o[d0][r] * rli[r]; ss += v * v; const float vq = v * gq[d0];
            const float b1 = __uint_as_float((unsigned)__builtin_amdgcn_update_dpp(0, (int)__float_as_uint(vq), 0x55, 0xF, 0xF, true));
            const float b2 = __uint_as_float((unsigned)__builtin_amdgcn_update_dpp(0, (int)__float_as_uint(vq), 0xAA, 0xF, 0xF, true));
            const float b3 = __uint_as_float((unsigned)__builtin_amdgcn_update_dpp(0, (int)__float_as_uint(vq), 0xFF, 0xF, 0xF, true));
            if ((r32e & 3) == 0) *(unsigned*)(Ow + (unsigned)(orow * LO + d0 * 32 + r32e)) = pk4_fp8(vq, b1, b2, b3); }
        ss += __uint_as_float((unsigned)__builtin_amdgcn_update_dpp(0, (int)__float_as_uint(ss), 0x111, 0xF, 0xF, true));
        ss += __uint_as_float((unsigned)__builtin_amdgcn_update_dpp(0, (int)__float_as_uint(ss), 0x112, 0xF, 0xF, true));
        ss += __uint_as_float((unsigned)__builtin_amdgcn_update_dpp(0, (int)__float_as_uint(ss), 0x114, 0xF, 0xF, true));
        ss += __uint_as_float((unsigned)__builtin_amdgcn_update_dpp(0, (int)__float_as_uint(ss), 0x118, 0xF, 0xF, true));
        if ((r32e & 15) == 15) atomicAdd(sq + 2 * orow, ss); } }
    __syncthreads();
#undef RESC
#undef KBASE
#undef MASKT
#undef SEAM_K0
#undef HALF_STEP
}
#undef VMW
#undef VMWN
#undef SLOAD_H
#undef SWRITE_HK
#undef SWRITE_HV
#undef SWRITE_H
}

constexpr int NWAVES = 8;
constexpr int BATCH = 4, SEQ = 2048, DM = 4096, M = BATCH * SEQ;
constexpr int HD = 128, NH_G = 16, WG_ = 2048;
constexpr int IN_COLS = 13392, IN_PAD = 13568, INA = 1280, INB = 12288;
constexpr int C_QA = 0, C_KA = 2048, C_VA = 4096, C_QB = 6144, C_KB = 8192, C_VB = 10240, C_QI = 12288, C_KI = 13312, C_WI = 13376;
constexpr int DFF = 11008, DFF2 = 22016, DFFP = 11264;
constexpr float ALPHA = 1.189207115002721f;
constexpr float LN_EPS = 1e-5f;
static_assert(att::LQ == IN_PAD && att::LO == DM, "attention strides");

constexpr size_t MiB = 1u << 20;
constexpr size_t WS_CTL = 0, CTL_ZERO_BYTES = 1 * MiB;
constexpr size_t WS_WIN = 1 * MiB;
constexpr size_t WS_WV = WS_WIN + 42 * MiB;
constexpr size_t WS_WOUT = WS_WIN + 106 * MiB;
constexpr size_t WS_WUP = WS_WOUT + 32 * MiB;
constexpr size_t WS_WDN = WS_WUP + 86 * MiB;
constexpr size_t WS_XH = WS_WDN + 43 * MiB;
constexpr size_t WS_PROJ = WS_XH + 64 * MiB;
constexpr size_t WS_Y = WS_PROJ + 212 * MiB;
constexpr size_t WS_MW = WS_Y + 64 * MiB;
constexpr size_t WS_M8 = WS_MW + 2 * MiB;
constexpr size_t WS_KBAR = WS_M8 + 512 * 1024;
constexpr size_t WS_STATS = WS_M8 + 768 * 1024;
constexpr size_t WS_SSQ = WS_M8 + 832 * 1024;
constexpr size_t WS_Z = WS_M8 + 1 * MiB;
constexpr size_t WS_X1Q = WS_Z + 128 * MiB;
constexpr size_t WS_U = WS_X1Q + 32 * MiB;
constexpr size_t WS_END = WS_U + 344 * MiB;
constexpr size_t WS_H = WS_PROJ;
static_assert((size_t)IN_PAD * DM * 2 == 106 * MiB && (size_t)DFF2 * DM == 86 * MiB && (size_t)DM * DFF == 43 * MiB && (size_t)M * IN_PAD * 2 == 212 * MiB && (size_t)M * DFF2 * 2 == 344 * MiB, "ws map");
constexpr float SC_Y = 16.f, SC_WO = 2048.f, SC_U = 32.f, SC_XQ = 16.f, SC_WV = 1024.f, FP8_MAX = 240.f;
constexpr float SC_H = 5.0f, SC_WDN = 2.0f / (0.0095311f * 0.5946035575f);
constexpr float SC_X1 = 2.0f, SC_WUP = 2.0f / (0.015625f * 0.5946035575f);
constexpr int CW_BAR = 4096;

constexpr int SCR_BYTES = 151552;
constexpr int LDSCTL_OFF = SCR_BYTES, MISC_OFF = LDSCTL_OFF + 320;
constexpr int LDS_BYTES = SCR_BYTES + 1024;
static_assert(att::ATT_LDS_BYTES <= SCR_BYTES && pg8::STAGE_BYTES <= SCR_BYTES, "LDS map");

#define GAS __attribute__((address_space(1)))
#define LAS __attribute__((address_space(3)))
typedef _Float16 f16;
typedef _Float16 h8 __attribute__((ext_vector_type(8)));
typedef unsigned v4u __attribute__((ext_vector_type(4)));
typedef float f32x4 __attribute__((ext_vector_type(4)));
typedef GAS unsigned gu32;
#define RLX_AGENT __ATOMIC_RELAXED, __HIP_MEMORY_SCOPE_AGENT
#define LDS_WAIT() asm volatile("s_waitcnt lgkmcnt(0)" ::: "memory")
#define VM_WAIT() asm volatile("s_waitcnt vmcnt(0)" ::: "memory")

#define XB_TMO      128
#define XB_XCNT(j)  (256  + 64 * (j))
#define XB_XSUB(j)  (1280 + 64 * (j))
#define XB_XGEN(j)  (2304 + 64 * (j))
#define XB_TOP      3328
#define XB_TOPGEN   3392
#define XCD_BAR_WORDS 3456
#define XB_SPIN_CAP (1u << 18)

__device__ __forceinline__ unsigned xb_ld(unsigned* p)              { return __hip_atomic_load(p, __ATOMIC_RELAXED, __HIP_MEMORY_SCOPE_AGENT); }
__device__ __forceinline__ unsigned xb_add(unsigned* p, unsigned v) { return __hip_atomic_fetch_add(p, v, __ATOMIC_RELAXED, __HIP_MEMORY_SCOPE_AGENT); }
__device__ __forceinline__ unsigned xb_xcc_id() { return (unsigned)__builtin_amdgcn_s_getreg((3 << 11) | 20) & 0xFu; }
#define XB_SPIN(cond, bar) do { unsigned _sp = 0; while (cond) { __builtin_amdgcn_s_sleep(1); \
    if ((++_sp & 255u) == 0u) { if (xb_ld(&(bar)[XB_TMO])) break; if (_sp > XB_SPIN_CAP) { atomicAdd(&(bar)[XB_TMO], 1u); break; } } } } while (0)

struct XcdBarrier {
    unsigned* bar; unsigned x;
    volatile LAS unsigned* st;
};

__device__ __forceinline__ XcdBarrier xcd_barrier_post(unsigned* bar, volatile LAS unsigned* st) {
    XcdBarrier b; b.bar = bar; b.x = xb_xcc_id(); b.st = st;
    if (threadIdx.x == 0) (void)xb_add(&bar[XB_XCNT(b.x)], 1u);
    return b;
}
__device__ __forceinline__ void xcd_barrier_complete(unsigned* bar, unsigned x, unsigned& nloc, unsigned& nx) {
    const unsigned G = gridDim.x * gridDim.y * gridDim.z;
    unsigned sum, cnt, mine, sp = 0u;
    for (;;) {
        sum = 0u; cnt = 0u; mine = 0u;
#pragma unroll
        for (unsigned j = 0; j < 16; ++j) { const unsigned c = xb_ld(&bar[XB_XCNT(j)]); sum += c; cnt += (c > 0u) ? 1u : 0u; mine = (j == x) ? c : mine; }
        if (sum == G) break;
        __builtin_amdgcn_s_sleep(1);
        if ((++sp & 255u) == 0u) { if (xb_ld(&bar[XB_TMO])) break; if (sp > XB_SPIN_CAP) { atomicAdd(&bar[XB_TMO], 1u); break; } }
    }
    nloc = mine > 0u ? mine : 1u; nx = cnt > 0u ? cnt : 1u;
}

__device__ __forceinline__ void xcd_barrier(const XcdBarrier& b) {
    asm volatile("s_waitcnt vmcnt(0)" ::: "memory");
    __syncthreads();
    if (threadIdx.x == 0) {
        unsigned* bar = b.bar;
        __builtin_amdgcn_s_waitcnt(0);
        unsigned nloc = b.st[0], nx = b.st[1];
        if (nloc == 0u) { xcd_barrier_complete(bar, b.x, nloc, nx); b.st[0] = nloc; b.st[1] = nx; }
        const unsigned old = xb_add(&bar[XB_XSUB(b.x)], 1u);
        const unsigned gen = old / nloc;
        if (old + 1u == (gen + 1u) * nloc) {
            __builtin_amdgcn_fence(__ATOMIC_RELEASE, "agent");
            asm volatile("s_waitcnt vmcnt(0)" ::: "memory");
            const unsigned og = xb_add(&bar[XB_TOP], 1u);
            const unsigned tg = og / nx;
            if (og + 1u == (tg + 1u) * nx) xb_add(&bar[XB_TOPGEN], 1u);
            else XB_SPIN(xb_ld(&bar[XB_TOPGEN]) == tg, bar);
            __builtin_amdgcn_fence(__ATOMIC_ACQUIRE, "agent");
            xb_add(&bar[XB_XGEN(b.x)], 1u);
            asm volatile("s_waitcnt vmcnt(0)" ::: "memory");
        } else {
            XB_SPIN(xb_ld(&bar[XB_XGEN(b.x)]) == gen, bar);
            __builtin_amdgcn_fence(__ATOMIC_ACQUIRE, "agent");
            asm volatile("s_waitcnt vmcnt(0)" ::: "memory");
        }
    }
    __syncthreads();
}


struct Frame {
    LAS unsigned char* lds;
    volatile LAS unsigned* MISC;
    gu32* ctl;
    int tid, lane, wave;
    int vcu, G;
};
__device__ __forceinline__ float wave_sum(float v) {
#pragma unroll
    for (int o = 1; o < 64; o <<= 1) v += __shfl_xor(v, o);
    return v;
}
__device__ __forceinline__ int wave_isum(int v) {
    int t = 0;
#pragma unroll
    for (int b = 0; b < 6; ++b) t += __builtin_popcountll(__ballot((v >> b) & 1)) << b;
    return t;
}
__device__ __forceinline__ unsigned pk2h(float lo, float hi) { return pg8::cvt_pk_f16(lo, hi); }

__device__ __forceinline__ void p0_tr_item(const float* W, int K, int N, f16* WT, const float* gain, LAS float* scr, int k0, int n0s, int n0, int lane) {
    const int kk = lane >> 4, c4 = (lane & 15) * 4;
    const bool inb = (n0s + c4) < N;
    f32x4 v[16];
#pragma unroll
    for (int i = 0; i < 16; ++i) v[i] = inb ? *(const f32x4*)(W + (size_t)(k0 + 4 * i + kk) * N + n0s + c4) : (f32x4){0.f, 0.f, 0.f, 0.f};
#pragma unroll
    for (int i = 0; i < 16; ++i) { const int k = 4 * i + kk; const float g = gain ? gain[k0 + k] : 1.f; LAS float* s = scr + k * 65 + c4;
        s[0] = v[i].x * g; s[1] = v[i].y * g; s[2] = v[i].z * g; s[3] = v[i].w * g; }
    LDS_WAIT(); asm volatile("" ::: "memory");
    const int c = lane & 7, nl = lane >> 3;
#pragma unroll
    for (int j = 0; j < 8; ++j) { const int n = nl + 8 * j; const LAS float* s = scr + (8 * c) * 65 + n;
        v4u o; o.x = pk2h(s[0 * 65], s[1 * 65]); o.y = pk2h(s[2 * 65], s[3 * 65]); o.z = pk2h(s[4 * 65], s[5 * 65]); o.w = pk2h(s[6 * 65], s[7 * 65]);
        *(GAS v4u*)(WT + (size_t)(n0 + n) * K + k0 + 8 * c) = o; }
    LDS_WAIT(); asm volatile("" ::: "memory");
}
__device__ __forceinline__ unsigned pk4_fp8(float a, float b, float c, float d) {
    a = __builtin_fminf(__builtin_fmaxf(a, -FP8_MAX), FP8_MAX); b = __builtin_fminf(__builtin_fmaxf(b, -FP8_MAX), FP8_MAX);
    c = __builtin_fminf(__builtin_fmaxf(c, -FP8_MAX), FP8_MAX); d = __builtin_fminf(__builtin_fmaxf(d, -FP8_MAX), FP8_MAX);
    int w = __builtin_amdgcn_cvt_pk_fp8_f32(a, b, 0, false); w = __builtin_amdgcn_cvt_pk_fp8_f32(c, d, w, true); return (unsigned)w; }
__device__ __forceinline__ unsigned pk8_fp4(float a, float b, float c, float d, float e, float f, float g, float h) {
    unsigned w = 0u;
    w = __builtin_amdgcn_cvt_scalef32_pk_fp4_f32(w, a, b, 1.0f, 0); w = __builtin_amdgcn_cvt_scalef32_pk_fp4_f32(w, c, d, 1.0f, 1);
    w = __builtin_amdgcn_cvt_scalef32_pk_fp4_f32(w, e, f, 1.0f, 2); w = __builtin_amdgcn_cvt_scalef32_pk_fp4_f32(w, g, h, 1.0f, 3); return w; }
__device__ __forceinline__ void p0_tr4_item(const float* W, int Kv, int K, int N, unsigned char* WT, float scale, LAS float* scr, int item, int lane) {
    typedef unsigned v2u __attribute__((ext_vector_type(2)));
    const int nblk = N / 32, kb = item / nblk, nb = item - kb * nblk, k0 = 128 * kb, n0 = 32 * nb;
    const int kk = lane >> 3, c4 = (lane & 7) * 4;
    f32x4 v[16];
#pragma unroll
    for (int i = 0; i < 16; ++i) v[i] = (k0 + 8 * i + kk < Kv) ? *(const f32x4*)(W + (size_t)(k0 + 8 * i + kk) * N + n0 + c4) : (f32x4){0.f, 0.f, 0.f, 0.f};
#pragma unroll
    for (int i = 0; i < 16; ++i) { LAS float* s = scr + (8 * i + kk) * 33 + c4; s[0] = v[i].x * scale; s[1] = v[i].y * scale; s[2] = v[i].z * scale; s[3] = v[i].w * scale; }
    LDS_WAIT(); asm volatile("" ::: "memory");
    const int c = lane & 7, nl = lane >> 3;
#pragma unroll
    for (int j = 0; j < 4; ++j) { const int n = nl + 8 * j; const LAS float* s = scr + (16 * c) * 33 + n;
        v2u o; o.x = pk8_fp4(s[0 * 33], s[1 * 33], s[2 * 33], s[3 * 33], s[4 * 33], s[5 * 33], s[6 * 33], s[7 * 33]);
        o.y = pk8_fp4(s[8 * 33], s[9 * 33], s[10 * 33], s[11 * 33], s[12 * 33], s[13 * 33], s[14 * 33], s[15 * 33]);
        *(GAS v2u*)(WT + (size_t)(n0 + n) * (K / 2) + (k0 + 16 * c) / 2) = o; }
    LDS_WAIT(); asm volatile("" ::: "memory");
}
__device__ __forceinline__ void p0_tr8_item(const float* W, int K, int N, unsigned char* WT, float scale, const float* gain, LAS float* scr, int k0, int n0s, int n0, int lane) {
    const int kk = lane >> 3, c4 = (lane & 7) * 4;
    f32x4 v[16];
#pragma unroll
    for (int i = 0; i < 16; ++i) v[i] = *(const f32x4*)(W + (size_t)(k0 + 8 * i + kk) * N + n0s + c4);
#pragma unroll
    for (int i = 0; i < 16; ++i) { LAS float* s = scr + (8 * i + kk) * 33 + c4; const float sg = gain ? scale * gain[k0 + 8 * i + kk] : scale;
        s[0] = v[i].x * sg; s[1] = v[i].y * sg; s[2] = v[i].z * sg; s[3] = v[i].w * sg; }
    LDS_WAIT(); asm volatile("" ::: "memory");
    const int c = lane & 7, nl = lane >> 3;
#pragma unroll
    for (int j = 0; j < 4; ++j) { const int n = nl + 8 * j; const LAS float* s = scr + (16 * c) * 33 + n;
        v4u o; o.x = pk4_fp8(s[0 * 33], s[1 * 33], s[2 * 33], s[3 * 33]); o.y = pk4_fp8(s[4 * 33], s[5 * 33], s[6 * 33], s[7 * 33]);
        o.z = pk4_fp8(s[8 * 33], s[9 * 33], s[10 * 33], s[11 * 33]); o.w = pk4_fp8(s[12 * 33], s[13 * 33], s[14 * 33], s[15 * 33]);
        *(GAS v4u*)(WT + (size_t)(n0 + n) * K + k0 + 16 * c) = o; }
    LDS_WAIT(); asm volatile("" ::: "memory");
}
struct P0Args { const float *x, *w_in, *w_out, *w_up, *w_down, *g_moba, *g_dsa; f16 *win_t; unsigned char *wv_t, *wout_t, *wup_t, *wdn_t; f16 *xh; unsigned char* xq; float* kbar; float* ssq; };
constexpr int P0_LD = 132;
static_assert(256 * P0_LD * 4 <= SCR_BYTES, "P0 tile fits");
struct P0Tile { const float* W; unsigned char* WT; int N, Kv, Nv, k0, n0s, n0d, fmt, rbd; float scale; };
__device__ __forceinline__ P0Tile p0_decode(const P0Args& a, int t) {
    constexpr int T_IN = (DM / 256) * (INA / 128), T_V = (DM / 256) * (INB / 128), T_OUT = (DM / 256) * (DM / 128), T_UP = (DM / 256) * (DFF2 / 128);
    P0Tile d;
    if (t < T_IN) { const int kb = t / (INA / 128), n0 = 128 * (t - kb * (INA / 128));
        d.W = a.w_in; d.WT = (unsigned char*)a.win_t; d.N = IN_COLS; d.Kv = DM; d.Nv = IN_COLS; d.k0 = 256 * kb; d.n0s = C_QI + n0; d.n0d = n0; d.fmt = 16; d.rbd = DM * 2; d.scale = 1.f; return d; }
    t -= T_IN;
    if (t < T_V) { const int kb = t / (INB / 128), n0 = 128 * (t - kb * (INB / 128));
        d.W = a.w_in; d.WT = a.wv_t; d.N = IN_COLS; d.Kv = DM; d.Nv = IN_COLS; d.k0 = 256 * kb; d.n0s = n0; d.n0d = n0; d.fmt = 8; d.rbd = DM; d.scale = SC_WV; return d; }
    t -= T_V;
    if (t < T_OUT) { const int kb = t / (DM / 128), n0 = 128 * (t - kb * (DM / 128));
        d.W = a.w_out; d.WT = a.wout_t; d.N = DM; d.Kv = DM; d.Nv = DM; d.k0 = 256 * kb; d.n0s = n0; d.n0d = n0; d.fmt = 8; d.rbd = DM; d.scale = SC_WO; return d; }
    t -= T_OUT;
    if (t < T_UP) { const int kb = t / (DFF2 / 128), dt = t - kb * (DFF2 / 128), n0 = 128 * dt;
        d.W = a.w_up; d.WT = a.wup_t; d.N = DFF2; d.Kv = DM; d.Nv = DFF2; d.k0 = 256 * kb; d.n0s = (dt & 1) * DFF + 128 * (dt >> 1); d.n0d = n0; d.fmt = 4; d.rbd = DM / 2; d.scale = SC_WUP; return d; }
    t -= T_UP;
    { const int kb = t / (DM / 128), n0 = 128 * (t - kb * (DM / 128));
      d.W = a.w_down; d.WT = a.wdn_t; d.N = DM; d.Kv = DFF; d.Nv = DM; d.k0 = 256 * kb; d.n0s = n0; d.n0d = n0; d.fmt = 4; d.rbd = DFFP / 2; d.scale = SC_WDN; return d; }
}
__device__ __forceinline__ void p0_tile_issue(f32x4 (&v)[16], const P0Tile& d, int) { const int tid = att::fresh_tid();
    const int n0c = d.n0s < d.Nv ? d.n0s : 0;
    const int c4 = (tid & 31) * 4, colc = n0c + c4 < d.Nv ? c4 : d.Nv - 4 - n0c;
    const unsigned voff = (unsigned)((tid >> 5) * d.N + colc) * 4u;
    const int k0c = d.k0 < d.Kv ? d.k0 : 0;
#pragma unroll
    for (int i = 0; i < 16; ++i) { const float* base = d.W + (size_t)(k0c + 16 * i) * d.N + n0c;
#if defined(__HIP_DEVICE_COMPILE__)
        asm volatile("s_nop 4\n\tglobal_load_dwordx4 %0, %1, %2" : "=v"(v[i]) : "v"(voff), "s"(base) : "memory");
#else
        v[i] = *(const f32x4*)(base + voff / 4);
#endif
    }
}
__device__ __forceinline__ void p0_tile_wait(f32x4 (&v)[16], int behind) {
#if defined(__HIP_DEVICE_COMPILE__)
#define P0_ALLV "+v"(v[0]), "+v"(v[1]), "+v"(v[2]), "+v"(v[3]), "+v"(v[4]), "+v"(v[5]), "+v"(v[6]), "+v"(v[7]), "+v"(v[8]), "+v"(v[9]), "+v"(v[10]), "+v"(v[11]), "+v"(v[12]), "+v"(v[13]), "+v"(v[14]), "+v"(v[15])
    if (behind == 16) asm volatile("s_waitcnt vmcnt(8)" : P0_ALLV :: "memory"); else if (behind == 8) asm volatile("s_waitcnt vmcnt(4)" : P0_ALLV :: "memory");
    else if (behind == 4) asm volatile("s_waitcnt vmcnt(2)" : P0_ALLV :: "memory"); else asm volatile("s_waitcnt vmcnt(0)" : P0_ALLV :: "memory");
#undef P0_ALLV
#endif
}
__device__ __forceinline__ void p0_tile_to_lds(const f32x4 (&v)[16], const P0Tile& d, LAS float* scr, int) { const int tid = att::fresh_tid();
    const int c4 = (tid & 31) * 4, kr = tid >> 5; const bool cin = d.n0s + c4 < d.Nv;
#pragma unroll
    for (int i = 0; i < 16; ++i) { const float sg = (cin && d.k0 + kr + 16 * i < d.Kv) ? d.scale : 0.f; *(LAS f32x4*)(scr + (kr + 16 * i) * P0_LD + c4) = v[i] * sg; }
}
__device__ __forceinline__ void p0_tile_store(const P0Tile& d, const LAS float* scr, int) { const int tid = att::fresh_tid();
    const int n = tid & 127, q = tid >> 7; const LAS float* s = scr + (64 * q) * P0_LD + n;
    unsigned char* dst = d.WT + (size_t)(d.n0d + n) * d.rbd;
    if (d.fmt == 16) { GAS v4u* o = (GAS v4u*)(dst + (size_t)(d.k0 + 64 * q) * 2);
#pragma unroll
        for (int j = 0; j < 8; ++j) { v4u w; w.x = pk2h(s[(8 * j + 0) * P0_LD], s[(8 * j + 1) * P0_LD]); w.y = pk2h(s[(8 * j + 2) * P0_LD], s[(8 * j + 3) * P0_LD]);
            w.z = pk2h(s[(8 * j + 4) * P0_LD], s[(8 * j + 5) * P0_LD]); w.w = pk2h(s[(8 * j + 6) * P0_LD], s[(8 * j + 7) * P0_LD]); o[j] = w; __builtin_amdgcn_sched_barrier(0); } }
    else if (d.fmt == 8) { GAS v4u* o = (GAS v4u*)(dst + (size_t)(d.k0 + 64 * q));
#pragma unroll
        for (int j = 0; j < 4; ++j) { v4u w;
            w.x = pk4_fp8(s[(16 * j + 0) * P0_LD], s[(16 * j + 1) * P0_LD], s[(16 * j + 2) * P0_LD], s[(16 * j + 3) * P0_LD]); w.y = pk4_fp8(s[(16 * j + 4) * P0_LD], s[(16 * j + 5) * P0_LD], s[(16 * j + 6) * P0_LD], s[(16 * j + 7) * P0_LD]);
            w.z = pk4_fp8(s[(16 * j + 8) * P0_LD], s[(16 * j + 9) * P0_LD], s[(16 * j + 10) * P0_LD], s[(16 * j + 11) * P0_LD]); w.w = pk4_fp8(s[(16 * j + 12) * P0_LD], s[(16 * j + 13) * P0_LD], s[(16 * j + 14) * P0_LD], s[(16 * j + 15) * P0_LD]); o[j] = w; __builtin_amdgcn_sched_barrier(0); } }
    else { GAS v4u* o = (GAS v4u*)(dst + (size_t)(d.k0 + 64 * q) / 2);
#pragma unroll
        for (int j = 0; j < 2; ++j) { v4u w;
#define P8_(b_) pk8_fp4(s[(32 * j + b_ + 0) * P0_LD], s[(32 * j + b_ + 1) * P0_LD], s[(32 * j + b_ + 2) * P0_LD], s[(32 * j + b_ + 3) * P0_LD], s[(32 * j + b_ + 4) * P0_LD], s[(32 * j + b_ + 5) * P0_LD], s[(32 * j + b_ + 6) * P0_LD], s[(32 * j + b_ + 7) * P0_LD])
            w.x = P8_(0); __builtin_amdgcn_sched_barrier(0); w.y = P8_(8); __builtin_amdgcn_sched_barrier(0); w.z = P8_(16); __builtin_amdgcn_sched_barrier(0); w.w = P8_(24); o[j] = w; __builtin_amdgcn_sched_barrier(0); }
#undef P8_
    }
}
constexpr int P0_NTILES = (DM / 256) * (INA / 128) + (DM / 256) * (INB / 128) + (DM / 256) * (DM / 128) + (DM / 256) * (DFF2 / 128) + (DFFP / 256) * (DM / 128);
constexpr int P0_DEFER_WGS0 = 160, P0_IDLE8_WGS0 = 192;
constexpr int P0_TF16 = (DM / 256) * (INA / 128), P0_T4LO = P0_TF16 + (DM / 256) * (INB / 128), P0_T2LO = P0_NTILES, P0_T3LO = P0_T2LO - 416;
static_assert(P0_T3LO >= P0_NTILES - (DFFP / 256) * (DM / 128), "the tiles converted during the up projection must be w_down tiles");
__device__ __forceinline__ void p0_tile_loop(Frame& F, const P0Args& a, int t0, int tend, int stride) {
    LAS float* scr = (LAS float*)F.lds;
    f32x4 vA[16], vB[16];
    int t = t0;
    if (t < tend) { P0Tile dA = p0_decode(a, t); p0_tile_issue(vA, dA, F.tid); p0_tile_wait(vA, 0);
        for (;;) {
            const int t1 = t + stride; const bool h1 = t1 < tend; const P0Tile dB = p0_decode(a, h1 ? t1 : t);
            p0_tile_issue(vB, dB, F.tid);
            p0_tile_to_lds(vA, dA, scr, F.tid); LDS_WAIT(); __syncthreads();
            p0_tile_store(dA, scr, F.tid); LDS_WAIT(); __syncthreads();
            p0_tile_wait(vB, dA.fmt);
            if (!h1) break;
            const int t2 = t1 + stride; const bool h2 = t2 < tend; dA = p0_decode(a, h2 ? t2 : t1);
            p0_tile_issue(vA, dA, F.tid);
            p0_tile_to_lds(vB, dB, scr, F.tid); LDS_WAIT(); __syncthreads();
            p0_tile_store(dB, scr, F.tid); LDS_WAIT(); __syncthreads();
            p0_tile_wait(vA, dB.fmt);
            if (!h2) break;
            t = t2;
        }
    }
}
__device__ __forceinline__ void p0_prologue(Frame& F, const P0Args& a) {
    { const size_t gt = (size_t)F.vcu * (NWAVES * 64) + F.tid, NT = (size_t)F.G * NWAVES * 64, TOT = (size_t)M * DM, STEP = NT * 8 * 4; typedef unsigned v2u __attribute__((ext_vector_type(2)));
      f32x4 pA[4], qA[4], pB[4], qB[4];
#define P0X_LOAD(p_, q_, i0_) do { _Pragma("unroll") for (int c = 0; c < 4; ++c) { const size_t i = (i0_) + (size_t)c * NT * 8; const size_t ic = i < TOT ? i : gt * 8; p_[c] = *(const f32x4*)(a.x + ic); q_[c] = *(const f32x4*)(a.x + ic + 4); } } while (0)
#define P0X_STORE(p_, q_, i0_) do { _Pragma("unroll") for (int c = 0; c < 4; ++c) { const size_t i = (i0_) + (size_t)c * NT * 8; if (i < TOT) { \
            v4u o; o.x = pk2h(p_[c].x, p_[c].y); o.y = pk2h(p_[c].z, p_[c].w); o.z = pk2h(q_[c].x, q_[c].y); o.w = pk2h(q_[c].z, q_[c].w); *(GAS v4u*)(a.xh + i) = o; \
            v2u oq; oq.x = pk4_fp8(p_[c].x * SC_XQ, p_[c].y * SC_XQ, p_[c].z * SC_XQ, p_[c].w * SC_XQ); oq.y = pk4_fp8(q_[c].x * SC_XQ, q_[c].y * SC_XQ, q_[c].z * SC_XQ, q_[c].w * SC_XQ); \
            *(GAS v2u*)(a.xq + i) = oq; } } } while (0)
      size_t i0 = gt * 8;
      P0X_LOAD(pA, qA, i0);
      for (; i0 < TOT; i0 += 2 * STEP) {
          P0X_LOAD(pB, qB, i0 + STEP);
          P0X_STORE(pA, qA, i0);
          P0X_LOAD(pA, qA, i0 + 2 * STEP);
          P0X_STORE(pB, qB, i0 + STEP);
      }
#undef P0X_LOAD
#undef P0X_STORE
    }
    for (int i = F.vcu * (NWAVES * 64) + F.tid; i < BATCH * 16 * 8 * 128; i += F.G * NWAVES * 64) a.kbar[i] = 0.f;
    for (int i = F.vcu * (NWAVES * 64) + F.tid; i < 2 * M; i += F.G * NWAVES * 64) a.ssq[i] = 0.f;
    p0_tile_loop(F, a, F.vcu, F.G == 256 ? P0_TF16 : P0_NTILES, F.G);
}

__device__ __forceinline__ void kbar_item(const f16* proj, float* kbar, int item, LAS float* scr, int tid) {
    const int n = item & 7, hh = (item >> 3) & 15, b = item >> 7;
    const int r = tid >> 4, c = (tid & 15) * 8;
    const f16* base = proj + (size_t)(b * SEQ + n * 256) * IN_PAD + C_KA + hh * HD + c;
    float s[8];
#pragma unroll
    for (int e = 0; e < 8; ++e) s[e] = 0.f;
#pragma unroll
    for (int j = 0; j < 8; ++j) { const h8 v = *(const h8*)(base + (size_t)(r + 32 * j) * IN_PAD);
#pragma unroll
        for (int e = 0; e < 8; ++e) s[e] += (float)v[e]; }
#pragma unroll
    for (int e = 0; e < 8; ++e) scr[r * 128 + c + e] = s[e];
    __syncthreads();
    if (tid < 128) { float t = 0.f;
#pragma unroll 8
        for (int r2 = 0; r2 < 32; ++r2) t += scr[r2 * 128 + tid];
        kbar[(size_t)item * 128 + tid] = t * (1.f / 256.f); }
    __syncthreads();
}

__device__ __forceinline__ void select_row(const LAS float* srow, int t, unsigned long long* outw, int lane) {
    unsigned long long myw = 0ull;
    if (t < 256) {
        const int lo = 64 * lane;
        myw = (lo + 63 <= t) ? ~0ull : (lo > t ? 0ull : ((1ull << (t - lo + 1)) - 1ull));
    } else {
        unsigned u[32];
#pragma unroll
        for (int i = 0; i < 32; ++i) { const int s = 64 * i + lane; const unsigned bts = __float_as_uint(srow[s]); const unsigned key = bts ^ ((bts >> 31) ? 0xffffffffu : 0x80000000u); u[i] = (s <= t) ? key : 0u; }
        const int ng = (t >> 8) + 1;
        unsigned T = 0u; bool exact = false;
        for (int bit = 31; bit >= 0; --bit) {
            const unsigned cand = T | (1u << bit); int c0 = 0, c1 = 0, c2 = 0, c3 = 0;
#if defined(__HIP_DEVICE_COMPILE__)
#define CNT4(cc, i0) do { unsigned long long m0_, m1_, m2_, m3_; asm volatile( \
                "v_cmp_ge_u32_e64 %1, %5, %9\n\tv_cmp_ge_u32_e64 %2, %6, %9\n\tv_cmp_ge_u32_e64 %3, %7, %9\n\tv_cmp_ge_u32_e64 %4, %8, %9\n\t" \
                "v_addc_co_u32_e64 %0, vcc, 0, %0, %1\n\tv_addc_co_u32_e64 %0, vcc, 0, %0, %2\n\tv_addc_co_u32_e64 %0, vcc, 0, %0, %3\n\tv_addc_co_u32_e64 %0, vcc, 0, %0, %4" \
                : "+v"(cc), "=&s"(m0_), "=&s"(m1_), "=&s"(m2_), "=&s"(m3_) : "v"(u[i0]), "v"(u[i0 + 1]), "v"(u[i0 + 2]), "v"(u[i0 + 3]), "v"(cand) : "vcc"); } while (0)
            CNT4(c0, 0); CNT4(c1, 4); if (ng > 2) CNT4(c2, 8); if (ng > 3) CNT4(c3, 12); if (ng > 4) CNT4(c0, 16); if (ng > 5) CNT4(c1, 20); if (ng > 6) CNT4(c2, 24); if (ng > 7) CNT4(c3, 28);
#undef CNT4
#endif
            const int c = (c0 + c1) + (c2 + c3);
            const int cnt = wave_isum(c);
            if (cnt >= 256) T = cand;
            if (cnt == 256) { exact = true; break; }
        }
        if (exact) {
#pragma unroll
            for (int i = 0; i < 32; ++i) if (i < 4 * ng) { const unsigned long long w = __ballot(u[i] >= T); if (lane == i) myw = w; }
        } else {
        int gtl = 0;
#pragma unroll
        for (int i = 0; i < 32; ++i) gtl += (u[i] > T) ? 1 : 0;
        const int need = 256 - wave_isum(gtl); int run = 0;
#pragma unroll
        for (int i = 0; i < 32; ++i) { const bool tie = (u[i] == T); const unsigned long long tb = __ballot(tie);
            const int below = (int)__builtin_amdgcn_mbcnt_hi((unsigned)(tb >> 32), __builtin_amdgcn_mbcnt_lo((unsigned)tb, 0u));
            const bool sel = (u[i] > T) || (tie && (run + below < need));
            const unsigned long long w = __ballot(sel); run += __builtin_popcountll(tb); if (lane == i) myw = w; }
        }
    }
    if (lane < 32) outw[lane] = myw;
}
constexpr int SC_LD = 2052;
static_assert(16 * SC_LD * 4 <= SCR_BYTES, "score tile fits");
__device__ __forceinline__ void dsa_index_unit(const f16* proj, unsigned long long* maskw, int b, int tq, LAS unsigned char* lds, int tid) {
    typedef float f4 __attribute__((ext_vector_type(4)));
    const int wid = __builtin_amdgcn_readfirstlane(tid >> 6), lane = tid & 63, fr = lane & 15, fq = lane >> 4;
    const int t0 = tq * 16, nkt = tq + 1;
    const f16* qrow = proj + (size_t)(b * SEQ + t0 + fr) * IN_PAD;
    h8 qf[16][2];
#pragma unroll
    for (int h = 0; h < 16; ++h)
#pragma unroll
        for (int kk = 0; kk < 2; ++kk) qf[h][kk] = *(const h8*)(qrow + C_QI + h * 64 + kk * 32 + fq * 8);
    float wv[16];
    { const h8 w0 = *(const h8*)(qrow + C_WI), w1 = *(const h8*)(qrow + C_WI + 8);
#pragma unroll
      for (int h = 0; h < 8; ++h) { wv[h] = (float)w0[h]; wv[8 + h] = (float)w1[h]; } }
    h8 qt[2];
#pragma unroll
    for (int kk = 0; kk < 2; ++kk)
#pragma unroll
        for (int e = 0; e < 8; ++e) { float a = 0.f;
#pragma unroll
            for (int h = 0; h < 16; ++h) a = __builtin_fmaf(wv[h], (float)qf[h][kk][e], a);
            qt[kk][e] = (_Float16)a; }
    LAS float* sc = (LAS float*)lds;
    const f16* kbase = proj + (size_t)(b * SEQ + fr) * IN_PAD + C_KI + fq * 8;
    h8 k0 = *(const h8*)(kbase + (size_t)((wid < nkt ? wid : nkt - 1) * 16) * IN_PAD), k1 = *(const h8*)(kbase + (size_t)((wid < nkt ? wid : nkt - 1) * 16) * IN_PAD + 32);
    for (int kt = wid; kt < nkt; kt += 8) {
        const int ktn = (kt + 8 < nkt) ? kt + 8 : nkt - 1;
        const h8 nk0 = *(const h8*)(kbase + (size_t)(ktn * 16) * IN_PAD), nk1 = *(const h8*)(kbase + (size_t)(ktn * 16) * IN_PAD + 32);
        f4 acc = {0.f, 0.f, 0.f, 0.f};
#pragma unroll
        for (int h = 0; h < 16; h += 2) { f4 ta = {0.f, 0.f, 0.f, 0.f}, tb = {0.f, 0.f, 0.f, 0.f};
            ta = __builtin_amdgcn_mfma_f32_16x16x32_f16(k0, qf[h][0], ta, 0, 0, 0);
            tb = __builtin_amdgcn_mfma_f32_16x16x32_f16(k0, qf[h + 1][0], tb, 0, 0, 0);
            ta = __builtin_amdgcn_mfma_f32_16x16x32_f16(k1, qf[h][1], ta, 0, 0, 0);
            tb = __builtin_amdgcn_mfma_f32_16x16x32_f16(k1, qf[h + 1][1], tb, 0, 0, 0);
#pragma unroll
            for (int j = 0; j < 4; ++j) acc[j] = __builtin_fmaf(wv[h], __builtin_fabsf(ta[j]), acc[j]);
#pragma unroll
            for (int j = 0; j < 4; ++j) acc[j] = __builtin_fmaf(wv[h + 1], __builtin_fabsf(tb[j]), acc[j]); }
        { f4 tl = {0.f, 0.f, 0.f, 0.f};
          tl = __builtin_amdgcn_mfma_f32_16x16x32_f16(k0, qt[0], tl, 0, 0, 0);
          tl = __builtin_amdgcn_mfma_f32_16x16x32_f16(k1, qt[1], tl, 0, 0, 0);
#pragma unroll
          for (int j = 0; j < 4; ++j) acc[j] += tl[j]; }
        *(LAS f4*)(sc + fr * SC_LD + kt * 16 + 4 * fq) = acc;
        k0 = nk0; k1 = nk1;
    }
    __syncthreads();
#pragma unroll 1
    for (int qq = 0; qq < 2; ++qq) { const int q = 2 * wid + qq, t = t0 + q;
        select_row(sc + q * SC_LD, t, maskw + (size_t)(b * SEQ + t) * 32, lane); }
    __syncthreads();
}

__device__ __forceinline__ void moba_gate_item(const f16* proj, const float* kbar, unsigned char* m8, int item, LAS float* kb, int tid) {
    const int qb = item & 7, hh = (item >> 3) & 15, b = item >> 7;
    for (int i = tid; i < qb * 128; i += NWAVES * 64) kb[i] = kbar[(size_t)((b * 16 + hh) * 8) * 128 + i];
    __syncthreads();
    { const int t = qb * 256 + (tid >> 1), hf = tid & 1; const f16* q = proj + (size_t)(b * SEQ + t) * IN_PAD + C_QA + hh * HD + hf * 64;
        float g[7];
#pragma unroll
        for (int n = 0; n < 7; ++n) g[n] = 0.f;
#pragma unroll 4
        for (int c = 0; c < 8; ++c) { const h8 v = *(const h8*)(q + c * 8);
#pragma unroll
            for (int n = 0; n < 7; ++n) if (n < qb) {
#pragma unroll
                for (int e = 0; e < 8; ++e) g[n] += (float)v[e] * kb[n * 128 + hf * 64 + c * 8 + e]; } }
#pragma unroll
        for (int n = 0; n < 7; ++n) g[n] += __uint_as_float((unsigned)__builtin_amdgcn_update_dpp(0, (int)__float_as_uint(g[n]), 0xB1, 0xF, 0xF, true));
        unsigned m = 1u << qb;
        if (qb <= 3) m |= (1u << qb) - 1u;
        else {
#pragma unroll
            for (int pick = 0; pick < 3; ++pick) { float bv = -3.0e38f; int bi = 0;
#pragma unroll
                for (int n = 0; n < 7; ++n) if (n < qb && !((m >> n) & 1u) && g[n] > bv) { bv = g[n]; bi = n; }
                m |= 1u << bi; } }
        if (hf == 0) m8[(size_t)(b * 16 + hh) * SEQ + t] = (unsigned char)m; }
    __syncthreads();
}

__device__ __forceinline__ att::Blk att_ref(int item, int second, unsigned char* YQ, float* SSQ, const float* g_moba, const float* g_dsa, const unsigned long long* MW, const unsigned char* M8) {
    const int dsa = item >> 8, idx = item & 255, b = idx >> 6, hh = (idx >> 2) & 15, p = idx & 3, qb = second ? 7 - p : p;
    att::Blk r; const size_t row0 = (size_t)b * SEQ;
    r.Q = (unsigned)(((row0 + qb * 256) * IN_PAD + (dsa ? C_QB : C_QA) + hh * HD) * 2);
    r.K = (unsigned)((row0 * IN_PAD + (dsa ? C_KB : C_KA) + hh * HD) * 2);
    r.V = (unsigned)((row0 * IN_PAD + (dsa ? C_VB : C_VA) + hh * HD) * 2);
    r.O = YQ + (row0 + qb * 256) * DM + dsa * WG_ + hh * HD; r.SQ = SSQ + 2 * (row0 + qb * 256) + dsa; r.G = (dsa ? g_dsa : g_moba) + hh * HD;
    r.MW = MW + (row0 + qb * 256) * 32;
    r.M8 = M8 + (size_t)(b * 16 + hh) * SEQ + qb * 256;
    r.P0 = qb * 256; r.dsa = dsa; return r;
}
__device__ __forceinline__ float t5_tab_entry(const float* rel, int hg, int dist) {
    if (dist < 0 || dist >= 113) return 0.f;
    int bucket = dist;
    if (dist >= 16) { bucket = 16; const int th[15] = {19, 21, 24, 27, 31, 35, 40, 46, 52, 59, 67, 77, 87, 99, 113};
#pragma unroll
        for (int i = 0; i < 15; ++i) bucket += (dist >= th[i]) ? 1 : 0; }
    return (rel[bucket * 32 + hg] - rel[31 * 32 + hg]) * (1.0f / att::SCALE);
}
__device__ __forceinline__ void attn_phase(Frame& F, char* lds, const f16* proj, unsigned char* YQ, float* SSQ, const float* g_moba, const float* g_dsa, const unsigned long long* MW, const unsigned char* M8, const float* rel, int part) {
    att::Seam S;
    const int item = part * 256 + F.vcu;
    const att::rsrc_t RS = __builtin_amdgcn_make_buffer_rsrc((void*)proj, 0, (int)((size_t)M * IN_PAD * 2), 0x00020000);
    att::Blk cur = att_ref(item, 0, YQ, SSQ, g_moba, g_dsa, MW, M8);
    att::attn_prime(cur, RS, lds, S);
#pragma unroll 1
    for (int i = 0; i < 2; ++i) {
        const att::Blk nxt = att_ref(item, 1, YQ, SSQ, g_moba, g_dsa, MW, M8);
        if (i == 0) {
            const int hg = (item >> 8) * 16 + (((item & 255) >> 2) & 15);
            const int ft = att::fresh_tid();
            ((LAS float*)((LAS char*)lds + att::TAB_OFF))[ft] = t5_tab_entry(rel, hg, ft - 256);
            __syncthreads();
        }
        att::attn_block(cur, nxt, RS, lds, S);
        cur = nxt;
    }
}

__device__ __forceinline__ void rms_rows(Frame& F, const f16* Y, unsigned char* YQ, const float* g_moba, const float* g_dsa) {
    const int gw = F.vcu * NWAVES + F.wave, NGW = F.G * NWAVES;
    f32x4 gg[8][2];
#pragma unroll
    for (int j = 0; j < 8; ++j) { const float* gp = (j < 4 ? g_moba : g_dsa - WG_) + 8 * F.lane + 512 * j; gg[j][0] = *(const f32x4*)gp; gg[j][1] = *(const f32x4*)(gp + 4); }
    for (int m = gw; m < M; m += NGW) { const GAS h8* yr = (const GAS h8*)(Y + (size_t)m * DM) + F.lane;
        h8 v[8]; float sa = 0.f, sb = 0.f;
#pragma unroll
        for (int j = 0; j < 8; ++j) { v[j] = yr[64 * j];
#pragma unroll
            for (int e = 0; e < 8; ++e) { const float f = (float)v[j][e]; if (j < 4) sa += f * f; else sb += f * f; } }
        const float ra = 1.f / sqrtf(wave_sum(sa) * (1.f / WG_) + LN_EPS), rb = 1.f / sqrtf(wave_sum(sb) * (1.f / WG_) + LN_EPS);
#pragma unroll
        for (int j = 0; j < 8; ++j) { const float r = (j < 4 ? ra : rb) * SC_Y; typedef unsigned v2u __attribute__((ext_vector_type(2))); v2u o;
            o.x = pk4_fp8((float)v[j][0] * r * gg[j][0].x, (float)v[j][1] * r * gg[j][0].y, (float)v[j][2] * r * gg[j][0].z, (float)v[j][3] * r * gg[j][0].w);
            o.y = pk4_fp8((float)v[j][4] * r * gg[j][1].x, (float)v[j][5] * r * gg[j][1].y, (float)v[j][6] * r * gg[j][1].z, (float)v[j][7] * r * gg[j][1].w);
            *((GAS v2u*)(YQ + (size_t)m * DM) + F.lane + 64 * j) = o; } }
}
__device__ __forceinline__ void ln_rows(Frame& F, const f16* Z, const float* g, const float* bta, float* outf, unsigned char* outq, float* stats) {
    const int gw = F.vcu * NWAVES + F.wave, NGW = F.G * NWAVES;
    for (int m = gw; m < M; m += NGW) { const GAS h8* zr = (const GAS h8*)(Z + (size_t)m * DM) + F.lane;
        f32x4 v[8][2]; float s = 0.f;
#pragma unroll
        for (int j = 0; j < 8; ++j) { const h8 zz = zr[64 * j];
            v[j][0] = (f32x4){(float)zz[0], (float)zz[1], (float)zz[2], (float)zz[3]}; v[j][1] = (f32x4){(float)zz[4], (float)zz[5], (float)zz[6], (float)zz[7]};
#pragma unroll
            for (int h = 0; h < 2; ++h) s += (v[j][h].x + v[j][h].y) + (v[j][h].z + v[j][h].w); }
        const float mean = wave_sum(s) * (1.f / DM); float s2 = 0.f;
#pragma unroll
        for (int j = 0; j < 8; ++j)
#pragma unroll
            for (int h = 0; h < 2; ++h) { v[j][h] = v[j][h] - mean; s2 += (v[j][h].x * v[j][h].x + v[j][h].y * v[j][h].y) + (v[j][h].z * v[j][h].z + v[j][h].w * v[j][h].w); }
        const float rstd = 1.f / sqrtf(wave_sum(s2) * (1.f / DM) + LN_EPS);
        if (stats && F.lane == 0) { stats[2 * (size_t)m] = mean; stats[2 * (size_t)m + 1] = rstd; }
        GAS f32x4* of = (GAS f32x4*)(outf + (size_t)m * DM) + 2 * F.lane;
#pragma unroll
        for (int j = 0; j < 8; ++j) { f32x4 y[2];
#pragma unroll
            for (int h = 0; h < 2; ++h) { const f32x4 gg = *((const GAS f32x4*)g + 2 * F.lane + 128 * j + h), bb = *((const GAS f32x4*)bta + 2 * F.lane + 128 * j + h);
                y[h] = v[j][h] * rstd * gg + bb; if (outf) of[128 * j + h] = y[h]; }
            if (outq) *((GAS unsigned*)(outq + (size_t)m * (DM / 2)) + F.lane + 64 * j) =
                pk8_fp4(y[0].x * SC_X1, y[0].y * SC_X1, y[0].z * SC_X1, y[0].w * SC_X1, y[1].x * SC_X1, y[1].y * SC_X1, y[1].z * SC_X1, y[1].w * SC_X1); } }
}
__device__ __forceinline__ void conv_gate(Frame& F, const unsigned char* U, const float* cw, const float* cb, unsigned char* H) {
    constexpr int NCC = DFFP / 8, RCH = 32, NRC = SEQ / RCH;
    const size_t gt = (size_t)F.vcu * (NWAVES * 64) + F.tid, NT = (size_t)F.G * NWAVES * 64, NIT = (size_t)BATCH * NRC * NCC;
    for (size_t it = gt; it < NIT; it += NT) {
        const int cc = (int)(it % NCC); const int rc = (int)((it / NCC) % NRC), b = (int)(it / ((size_t)NCC * NRC));
        const int c = cc * 8, r0 = rc * RCH;
        if (c >= DFF) { for (int r = 0; r < RCH; ++r) *(GAS unsigned*)(H + (size_t)(b * SEQ + r0 + r) * (DFFP / 2) + c / 2) = 0u; continue; }
        float w[2][3][8], bs[2][8];
#pragma unroll
        for (int s = 0; s < 2; ++s) {
#pragma unroll
            for (int j = 0; j < 3; ++j) { const f32x4 a = *(const f32x4*)(cw + (size_t)j * DFF2 + s * DFF + c), d = *(const f32x4*)(cw + (size_t)j * DFF2 + s * DFF + c + 4);
                const float iu = 1.f / SC_U;
                w[s][j][0] = a.x * iu; w[s][j][1] = a.y * iu; w[s][j][2] = a.z * iu; w[s][j][3] = a.w * iu; w[s][j][4] = d.x * iu; w[s][j][5] = d.y * iu; w[s][j][6] = d.z * iu; w[s][j][7] = d.w * iu; }
            const f32x4 a = *(const f32x4*)(cb + s * DFF + c), d = *(const f32x4*)(cb + s * DFF + c + 4);
            bs[s][0] = a.x; bs[s][1] = a.y; bs[s][2] = a.z; bs[s][3] = a.w; bs[s][4] = d.x; bs[s][5] = d.y; bs[s][6] = d.z; bs[s][7] = d.w; }
        typedef unsigned v2u __attribute__((ext_vector_type(2))); typedef float f2v __attribute__((ext_vector_type(2)));
        const unsigned char* ub = U + (size_t)(b * SEQ) * DFF2 + c;
#define UNPK8(dst, q) do { const f2v t0_ = __builtin_amdgcn_cvt_pk_f32_fp8((int)(q).x, false), t1_ = __builtin_amdgcn_cvt_pk_f32_fp8((int)(q).x, true), t2_ = __builtin_amdgcn_cvt_pk_f32_fp8((int)(q).y, false), t3_ = __builtin_amdgcn_cvt_pk_f32_fp8((int)(q).y, true); \
        dst[0] = t0_.x; dst[1] = t0_.y; dst[2] = t1_.x; dst[3] = t1_.y; dst[4] = t2_.x; dst[5] = t2_.y; dst[6] = t3_.x; dst[7] = t3_.y; } while (0)
        float p2[2][8], p1[2][8];
#pragma unroll
        for (int s = 0; s < 2; ++s) { v2u a = {0u, 0u}, d = {0u, 0u};
            if (r0 >= 2) { a = *(const v2u*)(ub + (size_t)(r0 - 2) * DFF2 + s * DFF); d = *(const v2u*)(ub + (size_t)(r0 - 1) * DFF2 + s * DFF); }
            UNPK8(p2[s], a); UNPK8(p1[s], d); }
#pragma unroll 8
        for (int r = 0; r < RCH; ++r) { const int t = r0 + r; float o[8];
            float cv[2][8];
#pragma unroll
            for (int s = 0; s < 2; ++s) { const v2u a = *(const v2u*)(ub + (size_t)t * DFF2 + s * DFF); float xa[8]; UNPK8(xa, a);
#pragma unroll
                for (int e = 0; e < 8; ++e) { const float x = xa[e]; cv[s][e] = w[s][0][e] * p2[s][e] + w[s][1][e] * p1[s][e] + w[s][2][e] * x + bs[s][e]; p2[s][e] = p1[s][e]; p1[s][e] = x; } }
#pragma unroll
            for (int e = 0; e < 8; ++e) { const float gte = cv[1][e]; o[e] = cv[0][e] * gte * __builtin_amdgcn_rcpf(1.f + __builtin_amdgcn_exp2f(-1.4426950408889634f * gte)); }
            *(GAS unsigned*)(H + (size_t)(b * SEQ + t) * (DFFP / 2) + c / 2) = pk8_fp4(o[0] * SC_H, o[1] * SC_H, o[2] * SC_H, o[3] * SC_H, o[4] * SC_H, o[5] * SC_H, o[6] * SC_H, o[7] * SC_H); }
    }
}

__device__ __forceinline__ void conv_fixup(Frame& F, const float* HB, const float* cw, const float* cb, unsigned char* H) {
    const size_t gt = (size_t)F.vcu * (NWAVES * 64) + F.tid, NT = (size_t)F.G * NWAVES * 64;
    constexpr int NCC = DFF / 8;
    for (size_t it = gt; it < (size_t)(M / 256) * NCC; it += NT) { const int pm = (int)(it / NCC), c = (int)(it % NCC) * 8;
        if ((pm & 7) == 0) continue;
        float r[2][4][8];
#pragma unroll
        for (int s = 0; s < 2; ++s)
#pragma unroll
            for (int k = 0; k < 4; ++k) { const float* p = HB + ((size_t)(k < 2 ? pm - 1 : pm) * 4 + (k < 2 ? 2 + k : k - 2)) * (2 * (size_t)DFF) + (size_t)s * DFF + c;
                const f32x4 a = *(const f32x4*)p, b = *(const f32x4*)(p + 4); r[s][k][0] = a.x; r[s][k][1] = a.y; r[s][k][2] = a.z; r[s][k][3] = a.w; r[s][k][4] = b.x; r[s][k][5] = b.y; r[s][k][6] = b.z; r[s][k][7] = b.w; }
#pragma unroll
        for (int q = 0; q < 2; ++q) { float hv[8];
#pragma unroll
            for (int e = 0; e < 8; ++e) { float cv[2];
#pragma unroll
                for (int s = 0; s < 2; ++s) { const size_t ch = (size_t)s * DFF + c + e; cv[s] = cw[ch] * r[s][q][e] + cw[DFF2 + ch] * r[s][q + 1][e] + cw[2 * (size_t)DFF2 + ch] * r[s][q + 2][e] + cb[ch]; }
                hv[e] = cv[0] * cv[1] * __builtin_amdgcn_rcpf(1.f + __builtin_amdgcn_exp2f(-1.4426950408889634f * cv[1])) * SC_H; }
            *(GAS unsigned*)(H + (size_t)(pm * 256 + q) * (DFFP / 2) + c / 2) = pk8_fp4(hv[0], hv[1], hv[2], hv[3], hv[4], hv[5], hv[6], hv[7]); }
    }
    for (size_t it = gt; it < (size_t)M * ((DFFP - DFF) / 8); it += NT) { const int row = (int)(it / ((DFFP - DFF) / 8)), c = DFF + (int)(it % ((DFFP - DFF) / 8)) * 8;
        *(GAS unsigned*)(H + (size_t)row * (DFFP / 2) + c / 2) = 0u; }
}

constexpr int N_PHASES = 12;
struct Args { const float* in[14]; float* out; unsigned char* ws; int ph_lo, ph_hi; };
__global__ void __launch_bounds__(NWAVES * 64, 2) fwd_kernel(Args args) {
    extern __shared__ __attribute__((aligned(16))) unsigned char lds[];
    Frame F;
    F.lds = (LAS unsigned char*)lds;
    F.MISC = (volatile LAS unsigned*)(F.lds + MISC_OFF);
    F.tid = threadIdx.x; F.lane = F.tid & 63; F.wave = __builtin_amdgcn_readfirstlane(F.tid >> 6);
    F.G = gridDim.x; { const int bx = blockIdx.x; F.vcu = (F.G % 8 == 0) ? (bx % 8) * (F.G / 8) + bx / 8 : bx; }
    F.ctl = (gu32*)(args.ws + WS_CTL);
    for (int u = F.tid; u < (LDS_BYTES - LDSCTL_OFF) / 4; u += NWAVES * 64) ((LAS unsigned*)(F.lds + LDSCTL_OFF))[u] = 0u;
    __syncthreads();
    const int lo = args.ph_lo, hi = args.ph_hi;
    const bool multi = true;
    XcdBarrier bar; bar.bar = (unsigned*)(F.ctl + CW_BAR); bar.x = 0; bar.st = nullptr;
    if (multi) bar = xcd_barrier_post((unsigned*)(F.ctl + CW_BAR), F.MISC + 8);
#ifndef PHASE_MASK
#define PHASE_MASK 0xFFF
#endif
#define IN(k) (lo <= (k) && (k) < hi && ((PHASE_MASK >> (k)) & 1))
#ifndef REPEAT_MASK
#define REPEAT_MASK 0
#endif
#define REP(k) for (int rep_ = 0; rep_ < (((REPEAT_MASK >> (k)) & 1) ? 2 : 1); ++rep_)
#define REPBAR(k) do { if (((REPEAT_MASK >> (k)) & 1) && rep_ == 0) xcd_barrier(bar); } while (0)
#define WSP(T, off) ((T*)(args.ws + (off)))
#define INP(i) (args.in[i])
#define SEAM(k) do { if (IN(k) && IN((k) + 1)) xcd_barrier(bar); } while (0)

    if (IN(0)) REP(0) { const P0Args a{INP(0), INP(1), INP(5), INP(8), INP(11), INP(3), INP(4), WSP(f16, WS_WIN), WSP(unsigned char, WS_WV), WSP(unsigned char, WS_WOUT), WSP(unsigned char, WS_WUP), WSP(unsigned char, WS_WDN), WSP(f16, WS_XH), WSP(unsigned char, WS_X1Q), WSP(float, WS_KBAR), WSP(float, WS_SSQ)};     p0_prologue(F, a); VM_WAIT(); __syncthreads(); REPBAR(0); }
    SEAM(0);
    if (IN(1)) {
        { pg8::Gemm g{WSP(const pg8::bf16_t, WS_XH), WSP(const pg8::bf16_t, WS_WIN), M, INA, DM}; pg8::StaticOrder S; S.init(M, INA, F.G, (int)blockIdx.x);
          pg8::EpiF16 E{WSP(pg8::bf16_t, WS_PROJ), IN_PAD, 1.f, 64, 64, C_QI, C_QI, C_QI, nullptr, 0, 0};
          pg8::gemm_phase<pg8::EpiF16, pg8::StaticOrder, true, true, 16, true>(F.lds, g, S, E); }
        if ((int)blockIdx.x >= P0_DEFER_WGS0 && F.G == 256) {
            const P0Args a{INP(0), INP(1), INP(5), INP(8), INP(11), INP(3), INP(4), WSP(f16, WS_WIN), WSP(unsigned char, WS_WV), WSP(unsigned char, WS_WOUT), WSP(unsigned char, WS_WUP), WSP(unsigned char, WS_WDN), WSP(f16, WS_XH), WSP(unsigned char, WS_X1Q), WSP(float, WS_KBAR), WSP(float, WS_SSQ)};
            p0_tile_loop(F, a, P0_TF16 + ((int)blockIdx.x - P0_DEFER_WGS0), P0_T4LO, 256 - P0_DEFER_WGS0);
            VM_WAIT(); __syncthreads(); }
        if (F.G == 256) xcd_barrier(bar);
        { pg8::Gemm g{WSP(const pg8::bf16_t, WS_X1Q), WSP(const pg8::bf16_t, WS_WV), M, INB, DM}; pg8::StaticOrder S; S.init(M, INB, F.G, (int)blockIdx.x);
          pg8::EpiF16 E{WSP(pg8::bf16_t, WS_PROJ), IN_PAD, 1.f / (SC_XQ * SC_WV), 64, 64, 0, 0, 0, WSP(float, WS_KBAR), 8, 16};
          pg8::gemm_phase<pg8::EpiF16, pg8::StaticOrder, false, true, 8, true>(F.lds, g, S, E); }
    }
    SEAM(1);
    if (IN(2)) REP(2) {
        for (int it = F.vcu; it < 256; it += F.G) { const int b = it >> 6, pr = it & 63;
#pragma unroll 1
            for (int k = 0; k < 2; ++k) dsa_index_unit(WSP(const f16, WS_PROJ), WSP(unsigned long long, WS_MW), b, k ? 127 - pr : pr, F.lds, F.tid); }
        for (int it = F.vcu; it < 512; it += F.G) moba_gate_item(WSP(const f16, WS_PROJ), WSP(const float, WS_KBAR), WSP(unsigned char, WS_M8), it, (LAS float*)F.lds, F.tid);
        REPBAR(2);
    }
    SEAM(2);
    if (IN(4)) {
        const P0Args a{INP(0), INP(1), INP(5), INP(8), INP(11), INP(3), INP(4), WSP(f16, WS_WIN), WSP(unsigned char, WS_WV), WSP(unsigned char, WS_WOUT), WSP(unsigned char, WS_WUP), WSP(unsigned char, WS_WDN), WSP(f16, WS_XH), WSP(unsigned char, WS_X1Q), WSP(float, WS_KBAR), WSP(float, WS_SSQ)};
        const int grp = (F.G == 256) ? (int)((blockIdx.x >> 3) % 3) : 3;
#pragma unroll 1
        for (int step = 0; step < 3; ++step) {
            if (step == grp) { VM_WAIT(); __syncthreads(); p0_tile_loop(F, a, P0_T4LO + F.vcu, P0_T3LO, F.G); VM_WAIT(); __syncthreads(); }
            else { const int part = step - (step > grp ? 1 : 0);
                if (part < 2) attn_phase(F, (char*)lds, WSP(const f16, WS_PROJ), WSP(unsigned char, WS_X1Q), WSP(float, WS_SSQ), INP(3), INP(4), WSP(const unsigned long long, WS_MW), WSP(const unsigned char, WS_M8), INP(2), part); }
        }
    }
    SEAM(4);
    if (IN(6)) { pg8::Gemm g{WSP(const pg8::bf16_t, WS_X1Q), WSP(const pg8::bf16_t, WS_WOUT), M, DM, DM}; pg8::StaticOrder S; S.init(M, DM, F.G, (int)blockIdx.x);
        pg8::EpiResHRms E{WSP(pg8::bf16_t, WS_Z), WSP(const pg8::bf16_t, WS_XH), WSP(const float, WS_SSQ), DM, ALPHA, 1.f / (att::SC_Y8 * SC_WO), 1.f / WG_, LN_EPS};
        pg8::gemm_phase<pg8::EpiResHRms, pg8::StaticOrder, true, true, 8, true>(F.lds, g, S, E); }
    SEAM(6);
    if (IN(7)) REP(7) { ln_rows(F, WSP(const f16, WS_Z), INP(6), INP(7), nullptr, WSP(unsigned char, WS_X1Q), WSP(float, WS_STATS));      REPBAR(7); }
    SEAM(7);
    if (IN(8)) { pg8::Gemm g{WSP(const pg8::bf16_t, WS_X1Q), WSP(const pg8::bf16_t, WS_WUP), M, DFF2, DM};   pg8::StaticOrder S; S.init(M, DFF2, F.G, (int)blockIdx.x);
        pg8::EpiConvGate E{WSP(unsigned char, WS_H), DFFP / 2, WSP(float, WS_U), INP(9), INP(10), DFF, 1.f / (SC_X1 * SC_WUP), SC_H, F.lds + 131072};
        pg8::gemm_phase<pg8::EpiConvGate, pg8::StaticOrder, true, true, 4, true>(F.lds, g, S, E);
        if ((int)blockIdx.x >= P0_IDLE8_WGS0 && F.G == 256) {
            const P0Args a{INP(0), INP(1), INP(5), INP(8), INP(11), INP(3), INP(4), WSP(f16, WS_WIN), WSP(unsigned char, WS_WV), WSP(unsigned char, WS_WOUT), WSP(unsigned char, WS_WUP), WSP(unsigned char, WS_WDN), WSP(f16, WS_XH), WSP(unsigned char, WS_X1Q), WSP(float, WS_KBAR), WSP(float, WS_SSQ)};
            p0_tile_loop(F, a, P0_T3LO + ((int)blockIdx.x - P0_IDLE8_WGS0), P0_T2LO, 256 - P0_IDLE8_WGS0); VM_WAIT(); __syncthreads(); } }
    SEAM(8);
    if (IN(9)) { conv_fixup(F, WSP(const float, WS_U), INP(9), INP(10), WSP(unsigned char, WS_H)); }
    SEAM(9);
    if (IN(10)) { pg8::Gemm g{WSP(const pg8::bf16_t, WS_H), WSP(const pg8::bf16_t, WS_WDN), M, DM, DFFP}; pg8::StaticOrder S; S.init(M, DM, F.G, (int)blockIdx.x);
        pg8::EpiLnResH E{WSP(pg8::bf16_t, WS_Z), WSP(const float, WS_STATS), INP(6), INP(7), DM, ALPHA, 1.f / (SC_H * SC_WDN)};
        pg8::gemm_phase<pg8::EpiLnResH, pg8::StaticOrder, true, true, 4, true>(F.lds, g, S, E); }
    SEAM(10);
    if (IN(11)) REP(11) { ln_rows(F, WSP(const f16, WS_Z), INP(12), INP(13), args.out, nullptr, nullptr); REPBAR(11); }
#undef IN
#undef SEAM
}

#ifndef MK_SINGLE
#define MK_SINGLE 1
#endif
extern "C" void kernel_launch(void* const* d_in, const int* in_sizes, int n_in, void* d_out, int out_size, void* d_ws, size_t ws_size, hipStream_t stream) {
    static int grid = 0;
    if (grid == 0) {
        if (n_in != 14 || in_sizes[0] != M * DM || out_size != M * DM || ws_size < WS_END) { fprintf(stderr, "kernel_launch: unexpected shapes (n_in %d, in0 %d, out %d, ws %zu < %zu); nothing launched\n", n_in, n_in > 0 ? in_sizes[0] : -1, out_size, ws_size, (size_t)WS_END); grid = -1; return; }
        int dev = 0, cus = 0, per_cu = 0;
        if (hipGetDevice(&dev) != hipSuccess || hipDeviceGetAttribute(&cus, hipDeviceAttributeMultiprocessorCount, dev) != hipSuccess) { grid = -1; return; }
        if (hipFuncSetAttribute((const void*)fwd_kernel, hipFuncAttributeMaxDynamicSharedMemorySize, LDS_BYTES) != hipSuccess) { fprintf(stderr, "kernel_launch: hipFuncSetAttribute failed\n"); grid = -1; return; }
        if (hipOccupancyMaxActiveBlocksPerMultiprocessor(&per_cu, (const void*)fwd_kernel, NWAVES * 64, LDS_BYTES) != hipSuccess || per_cu < 1)
            fprintf(stderr, "kernel_launch: note: occupancy query reports %d workgroups per CU\n", per_cu);
        (void)hipGetLastError();
        grid = cus;
        if (grid != 256) fprintf(stderr, "kernel_launch: note: %d CUs (built and tuned for 256)\n", grid);
    }
    if (grid < 0) return;
    (void)hipMemsetAsync((char*)d_ws + WS_CTL, 0, CTL_ZERO_BYTES, stream);
    Args a{};
    for (int i = 0; i < 14; ++i) a.in[i] = (const float*)d_in[i];
    a.out = (float*)d_out; a.ws = (unsigned char*)d_ws;
#if MK_SINGLE
    a.ph_lo = 0; a.ph_hi = N_PHASES;
    hipLaunchKernelGGL(fwd_kernel, dim3(grid), dim3(NWAVES * 64), LDS_BYTES, stream, a);
#else
    for (int p = 0; p < N_PHASES; ++p) { a.ph_lo = p; a.ph_hi = p + 1; hipLaunchKernelGGL(fwd_kernel, dim3(grid), dim3(NWAVES * 64), LDS_BYTES, stream, a); }
#endif
}
```

```cpp
#include <hip/hip_runtime.h>
#include <cstdio>
#include <cstdint>
namespace pg8 {
#define PG8_LAS __attribute__((address_space(3)))
typedef unsigned short bf16_t;
typedef _Float16 bf16x8 __attribute__((ext_vector_type(8)));
typedef float f32x4 __attribute__((ext_vector_type(4)));
typedef unsigned u32x4 __attribute__((ext_vector_type(4)));
constexpr int BM = 256, BK = 64, HALF = 128, HTB = HALF * BK * 2  , STAGE_BYTES = 8 * HTB, NXCD = 8, WGM = 8;

__host__ __device__ __forceinline__ int lds_byte(int r, int c) { const int st = (r >> 4) * 2 + (c >> 5), rr = r & 15, cc = c & 31, ob = rr * 64 + cc * 2; return st * 1024 + (ob ^ (((ob >> 9) & 1) << 5)); }
__host__ __device__ __forceinline__ void stage_rc(int b, int& R, int& C) { const int st = b / 1024, sb = b % 1024, swz = sb ^ (((sb >> 9) & 1) << 5); R = (st >> 1) * 16 + swz / 64; C = (st & 1) * 32 + (swz % 64) / 2; }
__host__ __device__ __forceinline__ int perm32(int rho) { const int n = rho >> 4, i = rho & 15; return 8 * (i >> 2) + 4 * n + (i & 3); }

struct Unit { int pm, pn; };
struct Gemm { const bf16_t* A; const bf16_t* Bt; int M, N, K; };

struct StaticOrder {
    int nM, nN, nwg, G, c;
    __host__ __device__ void init(int M, int N, int G_, int c_) { nM = M / BM; nN = N / BM; nwg = nM * nN; G = G_; c = c_; }
    __host__ __device__ bool next(int i, Unit& u) const {
        const long L = (long)i * G + c; if (L >= nwg) return false;
        int wgid = (int)L; { const int q = nwg / NXCD, r = nwg % NXCD, xcd = wgid % NXCD, off = wgid / NXCD; wgid = (xcd < r ? xcd * (q + 1) : r * (q + 1) + (xcd - r) * q) + off; }
        const int nig = WGM * nN, gid = wgid / nig, fm = gid * WGM, gsz = (nM - fm) < WGM ? (nM - fm) : WGM;
        u.pm = fm + ((wgid % nig) % gsz); u.pn = (wgid % nig) / gsz; return true;
    }
    __device__ __forceinline__ void a_ready(const Unit&) const {}
    __device__ __forceinline__ void done(const Unit&) const {}
};

__device__ __forceinline__ unsigned cvt_pk_f16(float lo, float hi) { typedef float f2v __attribute__((ext_vector_type(2))); typedef _Float16 h2v __attribute__((ext_vector_type(2)));
    return __builtin_bit_cast(unsigned, __builtin_convertvector((f2v){lo, hi}, h2v)); }
struct EpiF16 {
    static constexpr bool PERM = true, AFTER_DRAIN = false, HAS_MID = false;
    bf16_t* O; int ldc; float scale; int t0, t1, b0, b1, b2;
    float* kbar; int kt0, kt1;
    __device__ __forceinline__ void operator()(const f32x4 (&acc)[2][2][4][2], const Unit& u, int wr, int wc, int fr, int fq) const {
        const int colt = u.pn < t0 ? b0 + u.pn * BM : (u.pn < t1 ? b1 + (u.pn - t0) * BM : b2 + (u.pn - t1) * BM);
        const int row0 = u.pm * BM + wr * 64 + fr, col0 = colt + wc * 32 + 8 * fq;
        if (kbar && u.pn >= kt0 && u.pn < kt1) {
#pragma unroll
            for (int bj = 0; bj < 2; ++bj)
#pragma unroll
                for (int n = 0; n < 2; ++n) { f32x4 sm = acc[0][bj][0][n];
#pragma unroll
                    for (int ai = 0; ai < 2; ++ai)
#pragma unroll
                        for (int m = 0; m < 4; ++m) if (ai | m) sm += acc[ai][bj][m][n];
#pragma unroll
                    for (int j = 0; j < 4; ++j) { float v = sm[j];
                        v += __uint_as_float((unsigned)__builtin_amdgcn_update_dpp(0, (int)__float_as_uint(v), 0x111, 0xF, 0xF, true));
                        v += __uint_as_float((unsigned)__builtin_amdgcn_update_dpp(0, (int)__float_as_uint(v), 0x112, 0xF, 0xF, true));
                        v += __uint_as_float((unsigned)__builtin_amdgcn_update_dpp(0, (int)__float_as_uint(v), 0x114, 0xF, 0xF, true));
                        v += __uint_as_float((unsigned)__builtin_amdgcn_update_dpp(0, (int)__float_as_uint(v), 0x118, 0xF, 0xF, true));
                        if (fr == 15) { const int hh = 2 * (u.pn - kt0) + bj, d = wc * 32 + 8 * fq + 4 * n + j;
                            atomicAdd(kbar + ((size_t)(((u.pm >> 3) * 16 + hh) * 8 + (u.pm & 7))) * 128 + d, v * scale * (1.f / 256.f)); } } }
        }
#pragma unroll
        for (int ai = 0; ai < 2; ++ai)
#pragma unroll
            for (int m = 0; m < 4; ++m) { bf16_t* rowp = O + (size_t)(row0 + ai * HALF + m * 16) * ldc + col0;
#pragma unroll
                for (int bj = 0; bj < 2; ++bj) { const f32x4 v0 = acc[ai][bj][m][0] * scale, v1 = acc[ai][bj][m][1] * scale;
                    u32x4 w; w.x = cvt_pk_f16(v0[0], v0[1]); w.y = cvt_pk_f16(v0[2], v0[3]); w.z = cvt_pk_f16(v1[0], v1[1]); w.w = cvt_pk_f16(v1[2], v1[3]);
                    *(u32x4*)(rowp + bj * HALF) = w; } }
    }
};
struct EpiQ8 {
    static constexpr bool PERM = true, AFTER_DRAIN = false, HAS_MID = false;
    unsigned char* O; int ldc; float scale;
    __device__ __forceinline__ static unsigned pk4(f32x4 v) {
        const float a = __builtin_fminf(__builtin_fmaxf(v[0], -240.f), 240.f), b = __builtin_fminf(__builtin_fmaxf(v[1], -240.f), 240.f), c = __builtin_fminf(__builtin_fmaxf(v[2], -240.f), 240.f), d = __builtin_fminf(__builtin_fmaxf(v[3], -240.f), 240.f);
        int w = __builtin_amdgcn_cvt_pk_fp8_f32(a, b, 0, false); w = __builtin_amdgcn_cvt_pk_fp8_f32(c, d, w, true); return (unsigned)w; }
    __device__ __forceinline__ void operator()(const f32x4 (&acc)[2][2][4][2], const Unit& u, int wr, int wc, int fr, int fq) const {
        typedef unsigned u32x2 __attribute__((ext_vector_type(2)));
        const int row0 = u.pm * BM + wr * 64 + fr, col0 = u.pn * BM + wc * 32 + 8 * fq;
#pragma unroll
        for (int ai = 0; ai < 2; ++ai)
#pragma unroll
            for (int m = 0; m < 4; ++m) { unsigned char* rowp = O + (size_t)(row0 + ai * HALF + m * 16) * ldc + col0;
#pragma unroll
                for (int bj = 0; bj < 2; ++bj) { u32x2 w; w.x = pk4(acc[ai][bj][m][0] * scale); w.y = pk4(acc[ai][bj][m][1] * scale); *(u32x2*)(rowp + bj * HALF) = w; } }
    }
};
struct EpiConvGate {
    static constexpr bool PERM = true, AFTER_DRAIN = false, HAS_MID = false, PERMA = true;
    unsigned char* H; int ldh;
    float* HB;
    const float* cw; const float* cb;
    int dff; float dsc, sch;
    PG8_LAS unsigned char* xl;
    typedef float f2v __attribute__((ext_vector_type(2)));
    template <int CTRL> __device__ __forceinline__ static float dppf(float old, float src) { return __uint_as_float((unsigned)__builtin_amdgcn_update_dpp((int)__float_as_uint(old), (int)__float_as_uint(src), CTRL, 0xF, 0xF, false)); }
    __device__ __forceinline__ void operator()(const f32x4 (&acc)[2][2][4][2], const Unit& u, int wr, int wc, int fr, int fq) const {
        PG8_LAS float* X = (PG8_LAS float*)xl; PG8_LAS f32x4* TP = (PG8_LAS f32x4*)(xl + 16384);
        const int tid = ((wr * 4 + wc) << 6) + fq * 16 + fr, hc0 = 32 * wc + 8 * fq;
        if (tid < 256) { const int sgn = tid >> 7, hc = tid & 127; const size_t ch = (size_t)sgn * dff + (size_t)u.pn * 128 + hc;
            const float f = sgn ? 1.4426950408889634f : sch * 0.6931471805599453f, fd = f * dsc;
            PG8_LAS float* T = (PG8_LAS float*)TP + (sgn * 64 + (hc >> 1)) * 8 + (hc & 1);
            T[0] = cw[ch] * fd; T[2] = cw[2 * (size_t)dff + ch] * fd; T[4] = cw[4 * (size_t)dff + ch] * fd; T[6] = cb[ch] * f; }
        if (fr == 15) {
#pragma unroll
            for (int ai = 0; ai < 2; ++ai) { PG8_LAS f32x4* d = (PG8_LAS f32x4*)(X + ((((ai * 2 + wr) * 4 + wc) * 4 + fq) * 2) * 16);
#pragma unroll
                for (int k = 0; k < 2; ++k) { d[k * 4 + 0] = acc[ai][0][2 + k][0]; d[k * 4 + 1] = acc[ai][0][2 + k][1]; d[k * 4 + 2] = acc[ai][1][2 + k][0]; d[k * 4 + 3] = acc[ai][1][2 + k][1]; } } }
        { const bool first = (wr == 0 && fr == 0), last = (wr == 1 && fr == 15);
          if (first || last) {
#pragma unroll
              for (int k = 0; k < 2; ++k) { float* hb = HB + ((size_t)u.pm * 4 + (first ? k : 2 + k)) * (2 * (size_t)dff) + (size_t)u.pn * 128 + hc0;
#pragma unroll
                  for (int sgn = 0; sgn < 2; ++sgn)
#pragma unroll
                      for (int n = 0; n < 2; ++n) *(f32x4*)(hb + (size_t)sgn * dff + 4 * n) = (first ? acc[0][sgn][k][n] : acc[1][sgn][2 + k][n]) * dsc; } } }
        asm volatile("s_waitcnt lgkmcnt(0)" ::: "memory"); __builtin_amdgcn_s_barrier(); asm volatile("" ::: "memory");
#pragma unroll
        for (int ai = 0; ai < 2; ++ai) {
            f32x4 t14[2][2], t15[2][2];
            const bool hasprev = (wr == 1) || (ai == 1);
            if (hasprev) { const int pai = (wr == 1) ? ai : 0, pwr = (wr == 1) ? 0 : 1; const PG8_LAS f32x4* sp = (const PG8_LAS f32x4*)(X + ((((pai * 2 + pwr) * 4 + wc) * 4 + fq) * 2) * 16);
                t14[0][0] = sp[0]; t14[0][1] = sp[1]; t14[1][0] = sp[2]; t14[1][1] = sp[3]; t15[0][0] = sp[4]; t15[0][1] = sp[5]; t15[1][0] = sp[6]; t15[1][1] = sp[7]; }
            else {
#pragma unroll
                for (int a = 0; a < 2; ++a)
#pragma unroll
                    for (int b = 0; b < 2; ++b) { t14[a][b] = (f32x4){0.f, 0.f, 0.f, 0.f}; t15[a][b] = (f32x4){0.f, 0.f, 0.f, 0.f}; } }
            unsigned w[4] = {0u, 0u, 0u, 0u};
#pragma unroll
            for (int n = 0; n < 2; ++n) {
                int hcx = hc0 >> 1; asm volatile("" : "+v"(hcx));
                f2v cv[2][4][2];
#pragma unroll
                for (int sgn = 0; sgn < 2; ++sgn)
#pragma unroll
                    for (int jp = 0; jp < 2; ++jp) { const int j = 2 * jp;
                        const f2v x0 = {acc[ai][sgn][0][n][j], acc[ai][sgn][0][n][j + 1]}, x1 = {acc[ai][sgn][1][n][j], acc[ai][sgn][1][n][j + 1]},
                                  x2 = {acc[ai][sgn][2][n][j], acc[ai][sgn][2][n][j + 1]}, x3 = {acc[ai][sgn][3][n][j], acc[ai][sgn][3][n][j + 1]};
                        const f2v p3 = {dppf<0x111>(t15[sgn][n][j], x3.x), dppf<0x111>(t15[sgn][n][j + 1], x3.y)},
                                  p2 = {dppf<0x111>(t14[sgn][n][j], x2.x), dppf<0x111>(t14[sgn][n][j + 1], x2.y)};
                        const f32x4 ta = TP[(sgn * 64 + hcx + n * 2 + jp) * 2], tb = TP[(sgn * 64 + hcx + n * 2 + jp) * 2 + 1];
                        const f2v w0 = {ta.x, ta.y}, w1 = {ta.z, ta.w}, w2 = {tb.x, tb.y}, bb = {tb.z, tb.w};
                        cv[sgn][0][jp] = w0 * p2 + (w1 * p3 + (w2 * x0 + bb));
                        cv[sgn][1][jp] = w0 * p3 + (w1 * x0 + (w2 * x1 + bb));
                        cv[sgn][2][jp] = w0 * x0 + (w1 * x1 + (w2 * x2 + bb));
                        cv[sgn][3][jp] = w0 * x1 + (w1 * x2 + (w2 * x3 + bb)); }
#pragma unroll
                for (int m = 0; m < 4; ++m)
#pragma unroll
                    for (int jp = 0; jp < 2; ++jp) { const f2v g = cv[1][m][jp]; const f2v d = (f2v){__builtin_amdgcn_exp2f(-g.x), __builtin_amdgcn_exp2f(-g.y)} + (f2v){1.f, 1.f};
                        const f2v hv = cv[0][m][jp] * g * (f2v){__builtin_amdgcn_rcpf(d.x), __builtin_amdgcn_rcpf(d.y)};
                        if (n == 0) { if (jp == 0) w[m] = __builtin_amdgcn_cvt_scalef32_pk_fp4_f32(w[m], hv.x, hv.y, 1.0f, 0); else w[m] = __builtin_amdgcn_cvt_scalef32_pk_fp4_f32(w[m], hv.x, hv.y, 1.0f, 1); }
                        else { if (jp == 0) w[m] = __builtin_amdgcn_cvt_scalef32_pk_fp4_f32(w[m], hv.x, hv.y, 1.0f, 2); else w[m] = __builtin_amdgcn_cvt_scalef32_pk_fp4_f32(w[m], hv.x, hv.y, 1.0f, 3); } }
            }
#pragma unroll
            for (int m = 0; m < 4; ++m) { const int row = u.pm * BM + ai * HALF + wr * 64 + 4 * fr + m;
                *(unsigned*)(H + (size_t)row * ldh + ((size_t)u.pn * 128 + hc0) / 2) = w[m]; }
        }
    }
};
struct EpiResF32 {
    static constexpr bool PERM = false, AFTER_DRAIN = false, HAS_MID = false;
    float* C; const float* R; int ldc; float alpha, ascale;
    __device__ __forceinline__ void operator()(const f32x4 (&acc)[2][2][4][2], const Unit& u, int wr, int wc, int fr, int fq) const {
        const int row0 = u.pm * BM + wr * 64 + fr, col0 = u.pn * BM + wc * 32 + 4 * fq;
#pragma unroll
        for (int ai = 0; ai < 2; ++ai)
#pragma unroll
            for (int m = 0; m < 4; ++m) { const size_t off = (size_t)(row0 + ai * HALF + m * 16) * ldc + col0;
                f32x4 rv[2][2];
#pragma unroll
                for (int bj = 0; bj < 2; ++bj)
#pragma unroll
                    for (int n = 0; n < 2; ++n) rv[bj][n] = *(const f32x4*)(R + off + bj * HALF + n * 16);
#pragma unroll
                for (int bj = 0; bj < 2; ++bj)
#pragma unroll
                    for (int n = 0; n < 2; ++n) *(f32x4*)(C + off + bj * HALF + n * 16) = rv[bj][n] * alpha + acc[ai][bj][m][n] * ascale;
                asm volatile("" ::: "memory"); }
    }
};

typedef _Float16 h4v __attribute__((ext_vector_type(4)));
__device__ __forceinline__ f32x4 h4_to_f32(unsigned lo, unsigned hi) { typedef unsigned u2v __attribute__((ext_vector_type(2))); const h4v h = __builtin_bit_cast(h4v, (u2v){lo, hi}); return (f32x4){(float)h[0], (float)h[1], (float)h[2], (float)h[3]}; }
struct EpiResH {
    static constexpr bool PERM = true, AFTER_DRAIN = false, HAS_MID = false;
    bf16_t* Z; const float* R; int ldc; float alpha, ascale;
    __device__ __forceinline__ void operator()(const f32x4 (&acc)[2][2][4][2], const Unit& u, int wr, int wc, int fr, int fq) const {
        const int row0 = u.pm * BM + wr * 64 + fr, col0 = u.pn * BM + wc * 32 + 8 * fq;
#pragma unroll
        for (int ai = 0; ai < 2; ++ai)
#pragma unroll
            for (int m = 0; m < 4; ++m) { const size_t off = (size_t)(row0 + ai * HALF + m * 16) * ldc + col0;
                f32x4 rv[2][2];
#pragma unroll
                for (int bj = 0; bj < 2; ++bj)
#pragma unroll
                    for (int n = 0; n < 2; ++n) rv[bj][n] = *(const f32x4*)(R + off + bj * HALF + n * 4);
#pragma unroll
                for (int bj = 0; bj < 2; ++bj) { const f32x4 v0 = rv[bj][0] * alpha + acc[ai][bj][m][0] * ascale, v1 = rv[bj][1] * alpha + acc[ai][bj][m][1] * ascale;
                    u32x4 w; w.x = cvt_pk_f16(v0[0], v0[1]); w.y = cvt_pk_f16(v0[2], v0[3]); w.z = cvt_pk_f16(v1[0], v1[1]); w.w = cvt_pk_f16(v1[2], v1[3]);
                    *(u32x4*)(Z + off + bj * HALF) = w; }
                asm volatile("" ::: "memory"); }
    }
};
struct EpiResHRms {
    static constexpr bool PERM = true, AFTER_DRAIN = false, HAS_MID = true;
    bf16_t* Z; const bf16_t* Rh; const float* ssq; int ldc; float alpha, ascale, inv_w, eps;
    __device__ __forceinline__ void mid(f32x4 (&acc)[2][2][4][2], const Unit& u, int wr, int fr) const {
        typedef float f32x2 __attribute__((ext_vector_type(2)));
#pragma unroll
        for (int ai = 0; ai < 2; ++ai)
#pragma unroll
            for (int m = 0; m < 4; ++m) { const int row = u.pm * BM + ai * HALF + wr * 64 + m * 16 + fr; const f32x2 q = *(const f32x2*)(ssq + 2 * (size_t)row);
                const float ratio = __builtin_sqrtf((q.y * inv_w + eps) / (q.x * inv_w + eps));
#pragma unroll
                for (int bj = 0; bj < 2; ++bj)
#pragma unroll
                    for (int n = 0; n < 2; ++n) acc[ai][bj][m][n] = acc[ai][bj][m][n] * ratio; }
    }
    __device__ __forceinline__ void operator()(const f32x4 (&acc)[2][2][4][2], const Unit& u, int wr, int wc, int fr, int fq) const {
        const int row0 = u.pm * BM + wr * 64 + fr, col0 = u.pn * BM + wc * 32 + 8 * fq;
#pragma unroll
        for (int ai = 0; ai < 2; ++ai) {
            u32x4 rv[4][2]; float sq[4];
#pragma unroll
            for (int m = 0; m < 4; ++m) { const int row = row0 + ai * HALF + m * 16; const size_t off = (size_t)row * ldc + col0;
                sq[m] = ssq[2 * (size_t)row + 1];
#pragma unroll
                for (int bj = 0; bj < 2; ++bj) rv[m][bj] = *(const u32x4*)(Rh + off + bj * HALF); }
#pragma unroll
            for (int m = 0; m < 4; ++m) { const int row = row0 + ai * HALF + m * 16; const size_t off = (size_t)row * ldc + col0;
                const float rb = ascale / __builtin_sqrtf(sq[m] * inv_w + eps);
#pragma unroll
                for (int bj = 0; bj < 2; ++bj) { const f32x4 r0 = h4_to_f32(rv[m][bj].x, rv[m][bj].y), r1 = h4_to_f32(rv[m][bj].z, rv[m][bj].w);
                    const f32x4 v0 = r0 * alpha + acc[ai][bj][m][0] * rb, v1 = r1 * alpha + acc[ai][bj][m][1] * rb;
                    u32x4 w; w.x = cvt_pk_f16(v0[0], v0[1]); w.y = cvt_pk_f16(v0[2], v0[3]); w.z = cvt_pk_f16(v1[0], v1[1]); w.w = cvt_pk_f16(v1[2], v1[3]);
                    *(u32x4*)(Z + off + bj * HALF) = w; } }
            asm volatile("" ::: "memory"); }
    }
};
struct EpiLnResH {
    static constexpr bool PERM = true, AFTER_DRAIN = false, HAS_MID = false;
    bf16_t* Z; const float* stats; const float* g; const float* b; int ldc; float alpha, ascale;
    __device__ __forceinline__ void operator()(const f32x4 (&acc)[2][2][4][2], const Unit& u, int wr, int wc, int fr, int fq) const {
        typedef float f32x2 __attribute__((ext_vector_type(2)));
        const int row0 = u.pm * BM + wr * 64 + fr, col0 = u.pn * BM + wc * 32 + 8 * fq;
        f32x4 gv[2][2], bv[2][2];
#pragma unroll
        for (int bj = 0; bj < 2; ++bj)
#pragma unroll
            for (int n = 0; n < 2; ++n) { gv[bj][n] = *(const f32x4*)(g + col0 + bj * HALF + n * 4); bv[bj][n] = *(const f32x4*)(b + col0 + bj * HALF + n * 4); }
#pragma unroll
        for (int ai = 0; ai < 2; ++ai) {
            u32x4 zv[4][2]; f32x2 stv[4];
#pragma unroll
            for (int m = 0; m < 4; ++m) { const int row = row0 + ai * HALF + m * 16; const size_t off = (size_t)row * ldc + col0;
                stv[m] = *(const f32x2*)(stats + 2 * (size_t)row);
#pragma unroll
                for (int bj = 0; bj < 2; ++bj) zv[m][bj] = *(const u32x4*)(Z + off + bj * HALF); }
#pragma unroll
            for (int m = 0; m < 4; ++m) { const int row = row0 + ai * HALF + m * 16; const size_t off = (size_t)row * ldc + col0; const f32x2 st = stv[m];
#pragma unroll
                for (int bj = 0; bj < 2; ++bj) { const f32x4 z0 = h4_to_f32(zv[m][bj].x, zv[m][bj].y), z1 = h4_to_f32(zv[m][bj].z, zv[m][bj].w);
                    const f32x4 v0 = ((z0 - st.x) * st.y * gv[bj][0] + bv[bj][0]) * alpha + acc[ai][bj][m][0] * ascale, v1 = ((z1 - st.x) * st.y * gv[bj][1] + bv[bj][1]) * alpha + acc[ai][bj][m][1] * ascale;
                    u32x4 w; w.x = cvt_pk_f16(v0[0], v0[1]); w.y = cvt_pk_f16(v0[2], v0[3]); w.z = cvt_pk_f16(v1[0], v1[1]); w.w = cvt_pk_f16(v1[2], v1[3]);
                    *(u32x4*)(Z + off + bj * HALF) = w; } }
            asm volatile("" ::: "memory"); }
    }
};
struct EpiLnResF32 {
    static constexpr bool PERM = false, AFTER_DRAIN = false, HAS_MID = false;
    float* C; const float* R; const float* stats; const float* g; const float* b; int ldc; float alpha, ascale;
    __device__ __forceinline__ void operator()(const f32x4 (&acc)[2][2][4][2], const Unit& u, int wr, int wc, int fr, int fq) const {
        typedef float f32x2 __attribute__((ext_vector_type(2)));
        const int row0 = u.pm * BM + wr * 64 + fr, col0 = u.pn * BM + wc * 32 + 4 * fq;
        f32x4 gv[2][2], bv[2][2];
#pragma unroll
        for (int bj = 0; bj < 2; ++bj)
#pragma unroll
            for (int n = 0; n < 2; ++n) { gv[bj][n] = *(const f32x4*)(g + col0 + bj * HALF + n * 16); bv[bj][n] = *(const f32x4*)(b + col0 + bj * HALF + n * 16); }
#pragma unroll
        for (int ai = 0; ai < 2; ++ai)
#pragma unroll
            for (int m = 0; m < 4; ++m) { const int row = row0 + ai * HALF + m * 16; const size_t off = (size_t)row * ldc + col0;
                const f32x2 st = *(const f32x2*)(stats + 2 * (size_t)row);
                f32x4 rv[2][2];
#pragma unroll
                for (int bj = 0; bj < 2; ++bj)
#pragma unroll
                    for (int n = 0; n < 2; ++n) rv[bj][n] = *(const f32x4*)(R + off + bj * HALF + n * 16);
#pragma unroll
                for (int bj = 0; bj < 2; ++bj)
#pragma unroll
                    for (int n = 0; n < 2; ++n) *(f32x4*)(C + off + bj * HALF + n * 16) = ((rv[bj][n] - st.x) * st.y * gv[bj][n] + bv[bj][n]) * alpha + acc[ai][bj][m][n] * ascale;
                asm volatile("" ::: "memory"); }
    }
};
typedef int i32x4 __attribute__((ext_vector_type(4)));
typedef int i32x8 __attribute__((ext_vector_type(8)));
template <int FMT> struct Frag;
template <> struct Frag<16> { bf16x8 k[2]; };
template <> struct Frag<8> { i32x8 v; };
template <> struct Frag<4> { i32x4 k[2]; };
template <int FMT> __device__ __forceinline__ void frag_load(Frag<FMT>& f, const PG8_LAS unsigned char* p) {
    if constexpr (FMT == 16) { f.k[0] = *(const PG8_LAS bf16x8*)p; f.k[1] = *(const PG8_LAS bf16x8*)(p + 1024); }
    else if constexpr (FMT == 8) { const i32x4 lo = *(const PG8_LAS i32x4*)p, hi = *(const PG8_LAS i32x4*)(p + 1024); f.v = __builtin_shufflevector(lo, hi, 0, 1, 2, 3, 4, 5, 6, 7); }
    else { f.k[0] = *(const PG8_LAS i32x4*)p; f.k[1] = *(const PG8_LAS i32x4*)(p + 1024); }
}
template <int FMT> __device__ __forceinline__ f32x4 frag_mma(const Frag<FMT>& b, const Frag<FMT>& a, f32x4 c, int p) {
    if constexpr (FMT == 16) { return __builtin_amdgcn_mfma_f32_16x16x32_f16(b.k[p], a.k[p], c, 0, 0, 0); }
    else {
#if defined(__HIP_DEVICE_COMPILE__)
        if constexpr (FMT == 8) asm volatile("v_mfma_f32_16x16x128_f8f6f4 %0, %1, %2, %0" : "+v"(c) : "v"(b.v), "v"(a.v));
        else asm volatile("v_mfma_f32_16x16x128_f8f6f4 %0, %1, %2, %0 cbsz:4 blgp:4" : "+v"(c) : "v"(b.k[p]), "v"(a.k[p]));
#endif
        return c; }
}
template <class E, class = void> struct PermA { static constexpr bool v = false; };
template <class E> struct PermA<E, decltype((void)E::PERMA)> { static constexpr bool v = E::PERMA; };
template <class Epi, class Sched, bool ALIGN_EPI = false, bool SP2 = false, int FMT = 16, bool BAL = false>
__device__ __forceinline__ void gemm_phase(PG8_LAS unsigned char* lds, const Gemm g, const Sched& S, const Epi& E) {
    const int tid = threadIdx.x, wid = __builtin_amdgcn_readfirstlane(tid >> 6), lane = tid & 63, wr = wid >> 2, wc = wid & 3, fr = lane & 15, fq = lane >> 4;
    const int K = g.K, RB = K / 8 * FMT, nt = RB / 128;
    unsigned voffA[2], voffB[2];
#pragma unroll
    for (int i = 0; i < 2; ++i) { int R, C; stage_rc(tid * 16 + i * 8192, R, C); const int Rb = Epi::PERM ? ((R & ~31) + perm32(R & 31)) : R;
        const int Ra = PermA<Epi>::v ? ((R & ~63) + 4 * (R & 15) + ((R >> 4) & 3)) : R;
        voffA[i] = (unsigned)(Ra * RB + C * 2); voffB[i] = (unsigned)(Rb * RB + C * 2); }
    const size_t kstep = (size_t)(BK * 2);
    const size_t hstep = (size_t)HALF * RB;
    const size_t tstep = 2 * hstep;
    const unsigned ldsw = (unsigned)wid * 1024u;
    const int aoff = lds_byte(wr * 64 + fr, fq * 8), boff = lds_byte(wc * 32 + fr, fq * 8);
#define PG8_SA(b, h) (((b) * 2 + (h)) * HTB)
#define PG8_SB(b, h) ((4 + (b) * 2 + (h)) * HTB)
#define PG8_STAGE(bufoff, gbase, voff) do { _Pragma("unroll") for (int _i = 0; _i < 2; ++_i) \
        __builtin_amdgcn_global_load_lds((const unsigned*)((const char*)(gbase) + (voff)[_i]), (PG8_LAS unsigned*)(lds + (bufoff) + ldsw + _i * 8192), 16, 0, 0); } while (0)
#define PG8_LDA(dst, b, h) do { _Pragma("unroll") for (int m = 0; m < 4; ++m) frag_load<FMT>(dst[m], lds + PG8_SA(b, h) + aoff + m * 2048); } while (0)
#define PG8_LDB(dst, b, h) do { _Pragma("unroll") for (int n = 0; n < 2; ++n) frag_load<FMT>(dst[n], lds + PG8_SB(b, h) + boff + n * 2048); } while (0)
#define PG8_MMA(ai, bj, At, Bt) do { __builtin_amdgcn_s_setprio(1); \
        if constexpr (FMT == 16) { _Pragma("unroll") for (int m = 0; m < 4; ++m) _Pragma("unroll") for (int n = 0; n < 2; ++n) _Pragma("unroll") for (int k = 0; k < 2; ++k) \
            acc[ai][bj][m][n] = frag_mma<FMT>(Bt[n], At[m], acc[ai][bj][m][n], k); } \
        else { _Pragma("unroll") for (int k = 0; k < (FMT == 4 ? 2 : 1); ++k) _Pragma("unroll") for (int m = 0; m < 4; ++m) _Pragma("unroll") for (int n = 0; n < 2; ++n)     \
            acc[ai][bj][m][n] = frag_mma<FMT>(Bt[n], At[m], acc[ai][bj][m][n], k); } \
        __builtin_amdgcn_s_setprio(0); } while (0)
#define PG8_WAIT_V(n) asm volatile("s_waitcnt vmcnt(" #n ")" ::: "memory")
#define PG8_WAIT_L(n) asm volatile("s_waitcnt lgkmcnt(" #n ")" ::: "memory")
#define PG8_BAR __builtin_amdgcn_s_barrier()
#define PG8_SCHED __builtin_amdgcn_sched_barrier(0)
    Unit cur, nxt; int ui = 0;
    if (!S.next(0, cur)) return;
    f32x4 acc[2][2][4][2];
#pragma unroll
    for (int a = 0; a < 2; ++a)
#pragma unroll
        for (int b = 0; b < 2; ++b)
#pragma unroll
            for (int m = 0; m < 4; ++m)
#pragma unroll
                for (int n = 0; n < 2; ++n) acc[a][b][m][n] = (f32x4){0.f, 0.f, 0.f, 0.f};
    Frag<FMT> At[4], B0[2], B1[2];
    const char* cA = (const char*)g.A + (size_t)cur.pm * tstep; const char* cB = (const char*)g.Bt + (size_t)cur.pn * tstep;
    S.a_ready(cur);
    if constexpr (SP2 && BAL) {
        PG8_STAGE(PG8_SB(0, 0), cB, voffB); PG8_STAGE(PG8_SB(0, 1), cB + hstep, voffB); PG8_STAGE(PG8_SA(0, 0), cA, voffA); PG8_STAGE(PG8_SA(0, 1), cA + hstep, voffA);
        if (wr == 1) PG8_BAR;
        PG8_WAIT_V(2); PG8_BAR;
        PG8_STAGE(PG8_SB(1, 0), cB + kstep, voffB); PG8_STAGE(PG8_SB(1, 1), cB + hstep + kstep, voffB);
        PG8_WAIT_V(4); PG8_BAR;
    } else if constexpr (SP2) {
        PG8_STAGE(PG8_SB(0, 0), cB, voffB); PG8_STAGE(PG8_SB(0, 1), cB + hstep, voffB); PG8_STAGE(PG8_SA(0, 0), cA, voffA); PG8_STAGE(PG8_SA(0, 1), cA + hstep, voffA);
        if (wr == 1) PG8_BAR;
        PG8_WAIT_V(2); PG8_BAR;
        PG8_STAGE(PG8_SB(1, 0), cB + kstep, voffB); PG8_STAGE(PG8_SA(1, 0), cA + kstep, voffA); PG8_STAGE(PG8_SB(1, 1), cB + hstep + kstep, voffB);
        PG8_WAIT_V(6); PG8_BAR;
    } else {
        PG8_STAGE(PG8_SB(0, 0), cB, voffB); PG8_STAGE(PG8_SA(0, 0), cA, voffA); PG8_STAGE(PG8_SB(0, 1), cB + hstep, voffB); PG8_STAGE(PG8_SA(0, 1), cA + hstep, voffA);
        if (wr == 1) PG8_BAR;
        PG8_WAIT_V(4); PG8_BAR;
        PG8_STAGE(PG8_SB(1, 0), cB + kstep, voffB); PG8_STAGE(PG8_SA(1, 0), cA + kstep, voffA); PG8_STAGE(PG8_SB(1, 1), cB + hstep + kstep, voffB);
        PG8_WAIT_V(6); PG8_BAR;
    }
    for (;;) {
        const bool has_next = S.next(ui + 1, nxt);
        const char* nA = has_next ? (const char*)g.A + (size_t)nxt.pm * tstep : cA; const char* nB = has_next ? (const char*)g.Bt + (size_t)nxt.pn * tstep : cB;
        for (int t = 0; t < nt; t += 2) {
            if constexpr (Epi::HAS_MID) { if (t == (nt >> 1)) { if constexpr (FMT != 16) asm volatile("s_nop 15\n\ts_nop 15" ::: "memory"); E.mid(acc, cur, wr, fr); } }
            const bool last = (t == nt - 2);
            const char* a1 = cA + (size_t)(t + 1) * kstep;
            const char* a2 = last ? nA : cA + (size_t)(t + 2) * kstep; const char* b2 = last ? nB : cB + (size_t)(t + 2) * kstep;
            const char* a3 = a2 + kstep; const char* b3 = b2 + kstep;
            if (last && has_next) S.a_ready(nxt);
            if constexpr (SP2 && BAL) {
            PG8_LDB(B0, 0, 0); PG8_LDB(B1, 0, 1); PG8_SCHED; PG8_LDA(At, 0, 0); PG8_STAGE(PG8_SA(1, 0), a1, voffA); PG8_STAGE(PG8_SA(1, 1), a1 + hstep, voffA);
            PG8_WAIT_V(8); PG8_WAIT_L(0); PG8_BAR; PG8_MMA(0, 0, At, B0); PG8_MMA(0, 1, At, B1); PG8_BAR; PG8_SCHED;
            PG8_LDA(At, 0, 1); PG8_STAGE(PG8_SB(0, 0), b2, voffB); PG8_STAGE(PG8_SB(0, 1), b2 + hstep, voffB);
            PG8_WAIT_V(6); PG8_WAIT_L(0); PG8_BAR; PG8_MMA(1, 0, At, B0); PG8_MMA(1, 1, At, B1); PG8_BAR; PG8_SCHED;
            PG8_LDB(B0, 1, 0); PG8_LDB(B1, 1, 1); PG8_SCHED; PG8_LDA(At, 1, 0); PG8_STAGE(PG8_SA(0, 0), a2, voffA); PG8_STAGE(PG8_SA(0, 1), a2 + hstep, voffA);
            PG8_WAIT_V(8); PG8_WAIT_L(0); PG8_BAR; PG8_MMA(0, 0, At, B0); PG8_MMA(0, 1, At, B1); PG8_BAR; PG8_SCHED;
            PG8_LDA(At, 1, 1); PG8_STAGE(PG8_SB(1, 0), b3, voffB); PG8_STAGE(PG8_SB(1, 1), b3 + hstep, voffB);
            PG8_WAIT_V(6); PG8_WAIT_L(0); PG8_BAR; PG8_MMA(1, 0, At, B0); PG8_MMA(1, 1, At, B1); PG8_BAR; PG8_SCHED;
            (void)a3;
            } else if constexpr (SP2) {
            PG8_LDB(B0, 0, 0); PG8_LDB(B1, 0, 1); PG8_SCHED; PG8_LDA(At, 0, 0); PG8_STAGE(PG8_SA(1, 1), a1 + hstep, voffA);
            PG8_WAIT_V(8); PG8_WAIT_L(0); PG8_BAR; PG8_MMA(0, 0, At, B0); PG8_MMA(0, 1, At, B1); PG8_BAR; PG8_SCHED;
            PG8_LDA(At, 0, 1); PG8_STAGE(PG8_SB(0, 0), b2, voffB); PG8_STAGE(PG8_SB(0, 1), b2 + hstep, voffB); PG8_STAGE(PG8_SA(0, 0), a2, voffA);
            PG8_WAIT_V(8); PG8_WAIT_L(0); PG8_BAR; PG8_MMA(1, 0, At, B0); PG8_MMA(1, 1, At, B1); PG8_BAR; PG8_SCHED;
            PG8_LDB(B0, 1, 0); PG8_LDB(B1, 1, 1); PG8_SCHED; PG8_LDA(At, 1, 0); PG8_STAGE(PG8_SA(0, 1), a2 + hstep, voffA);
            PG8_WAIT_V(8); PG8_WAIT_L(0); PG8_BAR; PG8_MMA(0, 0, At, B0); PG8_MMA(0, 1, At, B1); PG8_BAR; PG8_SCHED;
            PG8_LDA(At, 1, 1); PG8_STAGE(PG8_SB(1, 0), b3, voffB); PG8_STAGE(PG8_SB(1, 1), b3 + hstep, voffB); PG8_STAGE(PG8_SA(1, 0), a3, voffA);
            PG8_WAIT_V(8); PG8_WAIT_L(0); PG8_BAR; PG8_MMA(1, 0, At, B0); PG8_MMA(1, 1, At, B1); PG8_BAR; PG8_SCHED;
            } else {
            PG8_LDB(B0, 0, 0); PG8_SCHED; PG8_LDA(At, 0, 0); PG8_STAGE(PG8_SA(1, 1), a1 + hstep, voffA);
            PG8_WAIT_L(8); PG8_BAR; PG8_WAIT_L(0); PG8_MMA(0, 0, At, B0); PG8_BAR; PG8_SCHED;
            PG8_LDB(B1, 0, 1); PG8_STAGE(PG8_SB(0, 0), b2, voffB);
            PG8_BAR; PG8_WAIT_L(0); PG8_MMA(0, 1, At, B1); PG8_BAR;
            PG8_LDA(At, 0, 1); PG8_STAGE(PG8_SA(0, 0), a2, voffA);
            PG8_BAR; PG8_WAIT_L(0); PG8_MMA(1, 0, At, B0); PG8_BAR; PG8_SCHED;
            PG8_STAGE(PG8_SB(0, 1), b2 + hstep, voffB);
            PG8_WAIT_V(6); PG8_BAR; PG8_MMA(1, 1, At, B1); PG8_BAR;
            PG8_LDB(B0, 1, 0); PG8_SCHED; PG8_LDA(At, 1, 0); PG8_STAGE(PG8_SA(0, 1), a2 + hstep, voffA);
            PG8_WAIT_L(8); PG8_BAR; PG8_WAIT_L(0); PG8_MMA(0, 0, At, B0); PG8_BAR; PG8_SCHED;
            PG8_LDB(B1, 1, 1); PG8_STAGE(PG8_SB(1, 0), b3, voffB);
            PG8_BAR; PG8_WAIT_L(0); PG8_MMA(0, 1, At, B1); PG8_BAR;
            PG8_LDA(At, 1, 1); PG8_STAGE(PG8_SA(1, 0), a3, voffA);
            PG8_BAR; PG8_WAIT_L(0); PG8_MMA(1, 0, At, B0); PG8_BAR; PG8_SCHED;
            PG8_STAGE(PG8_SB(1, 1), b3 + hstep, voffB);
            PG8_WAIT_V(6); PG8_BAR; PG8_MMA(1, 1, At, B1); PG8_BAR;
            }
        }
        if constexpr (FMT != 16) asm volatile("s_nop 15\n\ts_nop 15" ::: "memory");
        if constexpr (ALIGN_EPI) { if (wr == 0) PG8_BAR; }
        if constexpr (!Epi::AFTER_DRAIN) { E(acc, cur, wr, wc, fr, fq); S.done(cur); }
        if (!has_next) break;
#pragma unroll
        for (int a = 0; a < 2; ++a)
#pragma unroll
            for (int b = 0; b < 2; ++b)
#pragma unroll
                for (int m = 0; m < 4; ++m)
#pragma unroll
                    for (int n = 0; n < 2; ++n) acc[a][b][m][n] = (f32x4){0.f, 0.f, 0.f, 0.f};
        cur = nxt; cA = nA; cB = nB; ++ui;
        if constexpr (ALIGN_EPI) { if (wr == 1) PG8_BAR; }
    }
    PG8_WAIT_V(0);
    if constexpr (!ALIGN_EPI) { if (wr == 0) PG8_BAR; }
    PG8_BAR;
    if constexpr (Epi::AFTER_DRAIN) { E.fused(acc, cur, wr, wc, fr, fq, lds, wid, lane); S.done(cur); }
#undef PG8_SA
#undef PG8_SB
#undef PG8_STAGE
#undef PG8_LDA
#undef PG8_LDB
#undef PG8_MMA
#undef PG8_WAIT_V
#undef PG8_WAIT_L
#undef PG8_BAR
#undef PG8_SCHED
}
}

namespace att {
#define ATT_LAS __attribute__((address_space(3)))
constexpr int D = 128, NW = 8, QBLK = 32, KVBLK = 64, QB = NW * QBLK;
constexpr int LQ = 13568;
constexpr int LO = 4096;
constexpr int SHM_V = KVBLK * D * 2, SHM_K = KVBLK * D * 2;
constexpr int TAB_OFF = 2 * SHM_V + 2 * SHM_K + NW * 64 * 4;
constexpr int MSK_OFF = TAB_OFF + 2048, MSK_LD = 264;
constexpr int ATT_LDS_BYTES = MSK_OFF + 256 * MSK_LD;
constexpr float SCALE = 0.08838834764831845f;
constexpr float THR = 8.f;
typedef _Float16 f16;
typedef _Float16 h8 __attribute__((ext_vector_type(8)));
typedef short s16x4 __attribute__((ext_vector_type(4)));
typedef short s16x8 __attribute__((ext_vector_type(8)));
typedef float f32x16 __attribute__((ext_vector_type(16)));
typedef float f32x4 __attribute__((ext_vector_type(4)));
typedef unsigned u32x4 __attribute__((ext_vector_type(4)));

#define KSWZ(row, colB) ((row) * 256 + ((colB) ^ (((row) & 7) << 4)))
#define SBAR() __builtin_amdgcn_sched_barrier(0)
__device__ __forceinline__ int v_st(int k, int c) { const int kk = (k & ~0xC) | ((k & 4) << 1) | ((k & 8) >> 1); return ((kk >> 3) * 4 + (c >> 5)) * 512 + ((kk & 7) * 32 + (c & 31)) * 2; }
__device__ __forceinline__ int v_rd_base(int lane) { return ((lane & 3) << 3) | (((lane >> 2) & 3) << 6) | (((lane >> 4) & 1) << 5) | (((lane >> 5) & 1) << 8); }
constexpr int v_rd_off(int d0, int ks, int half) { return d0 * 512 + ks * 4096 + half * 2048; }
constexpr float SC_Y8 = 64.f;
__device__ __forceinline__ unsigned pk4_fp8(float a, float b, float c, float d) {
    a = __builtin_fminf(__builtin_fmaxf(a, -240.f), 240.f); b = __builtin_fminf(__builtin_fmaxf(b, -240.f), 240.f); c = __builtin_fminf(__builtin_fmaxf(c, -240.f), 240.f); d = __builtin_fminf(__builtin_fmaxf(d, -240.f), 240.f);
    int w = __builtin_amdgcn_cvt_pk_fp8_f32(a, b, 0, false); w = __builtin_amdgcn_cvt_pk_fp8_f32(c, d, w, true); return (unsigned)w; }
__device__ __forceinline__ int fresh_tid() { int t = threadIdx.x; asm volatile("" : "+v"(t)); return t; }
__device__ __forceinline__ int crow(int r, int hi) { return (r & 3) + 8 * (r >> 2) + 4 * hi; }
__device__ __forceinline__ unsigned cvtpk(float lo, float hi) { return pg8::cvt_pk_f16(lo, hi); }
__device__ __forceinline__ h8 load8(const f16* p) { return *reinterpret_cast<const h8*>(p); }
__device__ __forceinline__ float sel_or_ninf(float p, int keep  ) { return __uint_as_float((__float_as_uint(p) & (unsigned)keep) | (0xff800000u & ~(unsigned)keep)); }
__device__ __forceinline__ void mask_tile(f32x16& p0, f32x16& p1, int dq) {
    const float NEG = -__builtin_inff();
#pragma unroll
    for (int r = 0; r < 16; ++r) {
        const int c = (r & 3) + 8 * (r >> 2);
        if (dq - c < 0) p0[r] = NEG;
        if (dq - c - 32 < 0) p1[r] = NEG;
    }
}
__device__ __forceinline__ void dsa_mask(f32x16& p0, f32x16& p1, unsigned long long w, int hi) {
    const int lo = (int)(unsigned)(w >> (4 * hi)), hw = (int)(unsigned)(w >> (32 + 4 * hi));
#pragma unroll
    for (int r = 0; r < 16; ++r) {
        const int c = (r & 3) + 8 * (r >> 2);
        p0[r] = sel_or_ninf(p0[r], __builtin_amdgcn_sbfe(lo, c, 1));
        p1[r] = sel_or_ninf(p1[r], __builtin_amdgcn_sbfe(hw, c, 1));
    }
}
__device__ __forceinline__ void row_mask(f32x16& p0, f32x16& p1, int keep) {
#pragma unroll
    for (int r = 0; r < 16; ++r) { p0[r] = sel_or_ninf(p0[r], keep); p1[r] = sel_or_ninf(p1[r], keep); }
}
__device__ __forceinline__ void bias_tile(f32x16& p0, f32x16& p1, const ATT_LAS float* tp) {
#pragma unroll
    for (int g = 0; g < 4; ++g) {
        SBAR();
#pragma unroll
        for (int r = 4 * g; r < 4 * g + 4; ++r) {
            const int c = (r & 3) + 8 * (r >> 2);
            p0[r] += tp[60 - c];
            p1[r] += tp[28 - c];
        }
    }
    SBAR();
}
__device__ __forceinline__ void partialSM(f32x16& p0, f32x16& p1, float& m_reg, float& mn, float& alpha) {
    float pmax = p0[0]; for (int r = 1; r < 16; ++r) pmax = fmaxf(pmax, p0[r]); for (int r = 0; r < 16; ++r) pmax = fmaxf(pmax, p1[r]);
    { auto rr = __builtin_amdgcn_permlane32_swap(__float_as_uint(pmax), __float_as_uint(pmax), false, false);
      pmax = fmaxf(__uint_as_float(rr[0]), __uint_as_float(rr[1])); }
    constexpr float C2 = 1.4426950408889634f * SCALE;
    if (__builtin_expect(__all((pmax - m_reg) * SCALE <= THR), 1)) { mn = m_reg; alpha = 1.f; }
    else { mn = fmaxf(m_reg, pmax); alpha = __builtin_amdgcn_exp2f((m_reg - mn) * C2); m_reg = mn; }
    const float mnL = -mn * C2;
    for (int r = 0; r < 16; ++r) p0[r] = fmaf(p0[r], C2, mnL); for (int r = 0; r < 16; ++r) p1[r] = fmaf(p1[r], C2, mnL);
    for (int r = 0; r < 16; ++r) p0[r] = __builtin_amdgcn_exp2f(p0[r]);
}
__device__ __forceinline__ void finishSM(f32x16& p0, f32x16& p1, float alpha, float& l_reg, h8& pa0, h8& pa1, h8& pa2, h8& pa3) {
    for (int r = 0; r < 16; ++r) p1[r] = __builtin_amdgcn_exp2f(p1[r]);
    float ps = 0; for (int r = 0; r < 16; ++r) ps += p0[r]; for (int r = 0; r < 16; ++r) ps += p1[r];
    { auto rr = __builtin_amdgcn_permlane32_swap(__float_as_uint(ps), __float_as_uint(ps), false, false);
      ps = __uint_as_float(rr[0]) + __uint_as_float(rr[1]); }
    l_reg = l_reg * alpha + ps;
#define PK4(P, B_, OUT) do { unsigned a0 = cvtpk(P[B_+0], P[B_+1]), a1 = cvtpk(P[B_+2], P[B_+3]);                          \
        unsigned b0 = cvtpk(P[B_+4], P[B_+5]), b1 = cvtpk(P[B_+6], P[B_+7]);                                             \
        auto r0 = __builtin_amdgcn_permlane32_swap(a0, b0, false, false); auto r1 = __builtin_amdgcn_permlane32_swap(a1, b1, false, false); \
        u32x4 w = {r0[0], r1[0], r0[1], r1[1]}; OUT = __builtin_bit_cast(h8, w); } while (0)
    PK4(p0, 0, pa0); PK4(p0, 8, pa1); PK4(p1, 0, pa2); PK4(p1, 8, pa3);
#undef PK4
}
template <int KB>
__device__ __forceinline__ void qkt(f32x16& p0, f32x16& p1, const char* K_lds, int r32, int hi, const h8* qr) {
    p0 = f32x16{}; p1 = f32x16{};
    const char* kb[4];
#pragma unroll
    for (int dd = 0; dd < 4; ++dd) kb[dd] = K_lds + KB * SHM_K + KSWZ(r32, (dd * 16 + hi * 8) * 2);
#pragma unroll
    for (int d0 = 0; d0 < 8; ++d0) { const char* a = kb[d0 & 3] + (d0 >> 2) * 128;
        h8 b0 = *reinterpret_cast<const h8*>(a);
        h8 b1 = *reinterpret_cast<const h8*>(a + 32 * 256);
        p0 = __builtin_amdgcn_mfma_f32_32x32x16_f16(b0, qr[d0], p0, 0, 0, 0);
        p1 = __builtin_amdgcn_mfma_f32_32x32x16_f16(b1, qr[d0], p1, 0, 0, 0); }
}
template <int VB>
__device__ __forceinline__ void pv_tile(f32x16* o, int vb0, h8 pa0, h8 pa1, h8 pa2, h8 pa3) {
#define TRRD(dst, off) asm volatile("ds_read_b64_tr_b16 %0, %1 offset:%2" : "=&v"(dst) : "v"(vb0), "i"(off) : "memory")
#define HV8(l, h) __builtin_bit_cast(h8, (s16x8){l[0], l[1], l[2], l[3], h[0], h[1], h[2], h[3]})
#define PV_D0(d0) do { s16x4 l0, l1, l2, l3, h0, h1, h2, h3; constexpr int b_ = VB * SHM_V + v_rd_off(d0, 0, 0);     \
        TRRD(l0, b_); TRRD(h0, b_ + 2048); TRRD(l1, b_ + 4096); TRRD(h1, b_ + 6144); TRRD(l2, b_ + 8192); TRRD(h2, b_ + 10240); TRRD(l3, b_ + 12288); TRRD(h3, b_ + 14336); \
        asm volatile("s_waitcnt lgkmcnt(0)" ::: "memory"); SBAR();                 \
        o[d0] = __builtin_amdgcn_mfma_f32_32x32x16_f16(pa0, HV8(l0, h0), o[d0], 0, 0, 0);   \
        o[d0] = __builtin_amdgcn_mfma_f32_32x32x16_f16(pa1, HV8(l1, h1), o[d0], 0, 0, 0);   \
        o[d0] = __builtin_amdgcn_mfma_f32_32x32x16_f16(pa2, HV8(l2, h2), o[d0], 0, 0, 0);   \
        o[d0] = __builtin_amdgcn_mfma_f32_32x32x16_f16(pa3, HV8(l3, h3), o[d0], 0, 0, 0); } while (0)
    PV_D0(0); PV_D0(1); PV_D0(2); PV_D0(3);
#undef PV_D0
#undef HV8
#undef TRRD
}

struct Blk { unsigned Q, K, V; unsigned char* O; float* SQ; const float* G; const unsigned long long* MW; const unsigned char* M8; int P0; int dsa; };
typedef __amdgpu_buffer_rsrc_t rsrc_t;
__device__ __forceinline__ h8 bload8(rsrc_t r, unsigned voff, unsigned soff) { return __builtin_bit_cast(h8, __builtin_amdgcn_raw_buffer_load_b128(r, (int)voff, (int)soff, 0)); }
struct Seam { h8 qr[8]; h8 st_v0, st_v1, st_k0, st_k1; };
#define VMW() asm volatile("s_waitcnt vmcnt(0)" ::: "memory")
#define VMWN(n) asm volatile("s_waitcnt vmcnt(%0)" :: "i"(n) : "memory")
#define SLOAD_H(Kp, Vp, k0) do { const unsigned kp_ = (Kp) + (unsigned)(k0) * (LQ * 2), vp_ = (Vp) + (unsigned)(k0) * (LQ * 2);     \
                         S.st_v0 = bload8(RS, offA, vp_); S.st_v1 = bload8(RS, offB, vp_); S.st_k0 = bload8(RS, offA, kp_); S.st_k1 = bload8(RS, offB, kp_); } while (0)
#define SWRITE_HK(bf) do { *(h8*)(K_lds + (bf) * SHM_K + kws) = S.st_k0; *(h8*)(K_lds + (bf) * SHM_K + kws + 32 * 256) = S.st_k1; } while (0)
#define SWRITE_HV(bf) do { *(h8*)(V_lds + (bf) * SHM_V + vst0) = S.st_v0; *(h8*)(V_lds + (bf) * SHM_V + vst1) = S.st_v1; } while (0)
#define SWRITE_H(bf) do { SWRITE_HV(bf); SWRITE_HK(bf); } while (0)
__device__ __forceinline__ void attn_prime(const Blk& cur, rsrc_t RS, char* lds, Seam& S) {
    const int tid = threadIdx.x, wid = __builtin_amdgcn_readfirstlane(tid >> 6), lane = tid & 63, r32 = lane & 31, hi = lane >> 5;
    const int sr = tid >> 4, sc = (tid & 15) * 8, kws = KSWZ(sr, sc * 2); char* K_lds = lds + 2 * SHM_V;
    const unsigned offA = (unsigned)(sr * LQ + sc) * 2u, offB = offA + 64u * LQ, offQ = (unsigned)(r32 * LQ + hi * 8) * 2u;
    { const unsigned qb_ = cur.Q + (unsigned)(wid * QBLK) * (LQ * 2);
#pragma unroll
      for (int d0 = 0; d0 < 8; ++d0) S.qr[d0] = bload8(RS, offQ + d0 * 32, qb_); }
    SLOAD_H(cur.K, cur.V, 0); VMW(); SWRITE_HK(0);
    __syncthreads();
}
__device__ __forceinline__ void attn_block(const Blk& cur, const Blk& nxt, rsrc_t RS, char* lds, Seam& S) {
    const int tid = fresh_tid(), wid = __builtin_amdgcn_readfirstlane(tid >> 6), lane = tid & 63, r32 = lane & 31, hi = lane >> 5;
    const int NT = (cur.P0 + QB) / KVBLK;
    const int qlo = cur.P0 + wid * QBLK, qm = qlo + r32 - 4 * hi;
    char* V_lds = lds; char* K_lds = lds + 2 * SHM_V;
    float* ws = (float*)(lds + 2 * SHM_V + 2 * SHM_K) + wid * 64; float* li_l = ws, * al_l = ws + 32;
    const ATT_LAS float* tab0 = (const ATT_LAS float*)((ATT_LAS char*)lds + TAB_OFF) + 256 - 60;
    float m_reg = -1e30f, l_reg = 0; f32x16 o[4] = {};
    const int sr = tid >> 4, sc = (tid & 15) * 8, vst0 = v_st(sr, sc), vst1 = v_st(32 + sr, sc), kws = KSWZ(sr, sc * 2);
    const unsigned offA = (unsigned)(sr * LQ + sc) * 2u, offB = offA + 64u * LQ;
    const int vb0 = (int)(uintptr_t)V_lds + v_rd_base(lane);
    const unsigned Kh = cur.K, Vh = cur.V;
    const int dsa = cur.dsa;
    if (dsa) {
        const int ft = fresh_tid();
        const u32x4* src = (const u32x4*)(cur.MW + (size_t)(ft >> 1) * 32 + (ft & 1) * 16); u32x4 mv[8];
#pragma unroll
        for (int j = 0; j < 8; ++j) mv[j] = src[j];
        ATT_LAS unsigned long long* dst = (ATT_LAS unsigned long long*)((ATT_LAS char*)lds + MSK_OFF + (ft >> 1) * MSK_LD + (ft & 1) * 128);
#pragma unroll
        for (int j = 0; j < 8; ++j) { dst[2 * j] = ((unsigned long long)mv[j].y << 32) | mv[j].x; dst[2 * j + 1] = ((unsigned long long)mv[j].w << 32) | mv[j].z; }
        __syncthreads();
    }
    const ATT_LAS unsigned long long* mrow = (const ATT_LAS unsigned long long*)((ATT_LAS char*)lds + MSK_OFF + (wid * QBLK + r32) * MSK_LD);
    const int m8 = (int)cur.M8[wid * QBLK + r32];
#define RESC(a) do { if (__any((a) < 1.f)) { if (hi == 0) al_l[r32] = (a); asm volatile("s_waitcnt lgkmcnt(0)" ::: "memory");              \
                     for (int d_ = 0; d_ < 4; ++d_) for (int r = 0; r < 16; ++r) o[d_][r] *= al_l[crow(r, hi)]; } } while (0)
#define KBASE(t) ((t) * KVBLK)
#define MASKT(P0_, P1_, t) do { const int kb_ = KBASE(t);                                                                  \
        if (kb_ + KVBLK - 1 + 113 > qlo) bias_tile(P0_, P1_, tab0 + (qm - kb_));                                                  \
        if (dsa) dsa_mask(P0_, P1_, mrow[(t)], hi);                                                                                     \
        else if (kb_ < cur.P0) { const int keep_ = -((m8 >> (kb_ >> 8)) & 1); if (!__all(keep_ != 0)) row_mask(P0_, P1_, keep_); } \
        else if (kb_ + KVBLK - 1 > qlo) mask_tile(P0_, P1_, qm - kb_); } while (0)
#define SEAM_K0() do { VMWN(8); SWRITE_HK(0); SBAR(); } while (0)
    f32x16 pA0, pA1, pB0, pB1; float mnA, mnB, alA, alB; h8 pa0, pa1, pa2, pa3;
    SWRITE_HV(0); SBAR();
    if (NT > 1) { SLOAD_H(Kh, Vh, KBASE(1)); }
    SBAR(); qkt<0>(pA0, pA1, K_lds, r32, hi, S.qr);
    MASKT(pA0, pA1, 0); partialSM(pA0, pA1, m_reg, mnA, alA);
    if (NT > 1) { VMW(); SWRITE_H(1); }
    __syncthreads();
#define HALF_STEP(PX0, PX1, mnX, alX, PY0, PY1, alY, t, KB, VB, SB) do {                                                 \
        SBAR(); finishSM(PY0, PY1, alY, l_reg, pa0, pa1, pa2, pa3); SBAR();     \
        qkt<KB>(PX0, PX1, K_lds, r32, hi, S.qr); SBAR();                                                                      \
        if ((t) + 1 < NT) { SLOAD_H(Kh, Vh, KBASE((t) + 1)); SBAR(); }                                                         \
        pv_tile<VB>(o, vb0, pa0, pa1, pa2, pa3); MASKT(PX0, PX1, (t)); partialSM(PX0, PX1, m_reg, mnX, alX);              \
        __syncthreads();                                                                                                      \
        if ((t) + 1 < NT) { VMW(); SWRITE_H(SB); }                                                                             \
        RESC(alX); __syncthreads(); } while (0)
    for (int t = 1; t + 1 < NT; t += 2) {
        HALF_STEP(pB0, pB1, mnB, alB, pA0, pA1, alA, t, 1, 0, 0);
        HALF_STEP(pA0, pA1, mnA, alA, pB0, pB1, alB, t + 1, 0, 1, 1);
    }
    const bool even = (NT & 1) == 0;
    SBAR(); finishSM(pA0, pA1, alA, l_reg, pa0, pa1, pa2, pa3); SBAR();
    if (even) { qkt<1>(pB0, pB1, K_lds, r32, hi, S.qr); SBAR(); }
    { SLOAD_H(nxt.K, nxt.V, 0); SBAR(); const int ft = fresh_tid(); const unsigned qb_ = nxt.Q + (unsigned)(__builtin_amdgcn_readfirstlane(ft >> 6) * QBLK) * (LQ * 2);
      const unsigned offQ = (unsigned)((ft & 31) * LQ + ((ft >> 5) & 1) * 8) * 2u;
#pragma unroll
      for (int d0 = 0; d0 < 8; ++d0) S.qr[d0] = bload8(RS, offQ + d0 * 32, qb_); }
    SBAR();
    pv_tile<0>(o, vb0, pa0, pa1, pa2, pa3);
    if (even) { MASKT(pB0, pB1, NT - 1); partialSM(pB0, pB1, m_reg, mnB, alB); __syncthreads(); RESC(alB);
        finishSM(pB0, pB1, alB, l_reg, pa0, pa1, pa2, pa3); SBAR(); pv_tile<1>(o, vb0, pa0, pa1, pa2, pa3); }
    SBAR(); SEAM_K0();
    { const int ft = fresh_tid(), r32e = ft & 31, hie = (ft >> 5) & 1, wide = __builtin_amdgcn_readfirstlane(ft >> 6);
      float* li_e = (float*)(lds + 2 * SHM_V + 2 * SHM_K) + wide * 64;
      if (hie == 0) li_e[r32e] = l_reg; asm volatile("s_waitcnt lgkmcnt(0)" ::: "memory");
      float rli[16];
#pragma unroll
      for (int r = 0; r < 16; ++r) rli[r] = __builtin_amdgcn_rcpf(li_e[crow(r, hie)]);
      unsigned char* Ow = cur.O + (size_t)(wide * QBLK) * LO; float* sq = cur.SQ + 2 * (wide * QBLK);
      float gq[4];
#pragma unroll
      for (int d0 = 0; d0 < 4; ++d0) gq[d0] = cur.G[d0 * 32 + r32e] * SC_Y8;
#pragma unroll
      for (int r = 0; r < 16; ++r) { const int orow = crow(r, hie); float ss = 0.f;
#pragma unroll
        for (int d0 = 0; d0 < 4; ++d0) { const float v = o[d0][r] * rli[r]; ss += v * v; const float vq = v * gq[d0];
            const float b1 = __uint_as_float((unsigned)__builtin_amdgcn_update_dpp(0, (int)__float_as_uint(vq), 0x55, 0xF, 0xF, true));
            const float b2 = __uint_as_float((unsigned)__builtin_amdgcn_update_dpp(0, (int)__float_as_uint(vq), 0xAA, 0xF, 0xF, true));
            const float b3 = __uint_as_float((unsigned)__builtin_amdgcn_update_dpp(0, (int)__float_as_uint(vq), 0xFF, 0xF, 0xF, true));
            if ((r32e & 3) == 0) *(unsigned*)(Ow + (unsigned)(orow * LO + d0 * 32 + r32e)) = pk4_fp8(vq, b1, b2, b3); }
        ss += __uint_as_float((unsigned)__builtin_amdgcn_update_dpp(0, (int)__float_as_uint(ss), 0x111, 0xF, 0xF, true));
        ss += __uint_as_float((unsigned)__builtin_amdgcn_update_dpp(0, (int)__float_as_uint(ss), 0x112, 0xF, 0xF, true));
        ss += __uint_as_float((unsigned)__builtin_amdgcn_update_dpp(0, (int)__float_as_uint(ss), 0x114, 0xF, 0xF, true));
        ss += __uint_as_float((unsigned)__builtin_amdgcn_update_dpp(0, (int)__float_as_uint(ss), 0x118, 0xF, 0xF, true));
        if ((r32e & 15) == 15) atomicAdd(sq + 2 * orow, ss); } }
    __syncthreads();
#undef RESC
#undef KBASE
#undef MASKT
#undef SEAM_K0
#undef HALF_STEP
}
#undef VMW
#undef VMWN
#undef SLOAD_H
#undef SWRITE_HK
#undef SWRITE_HV
#undef SWRITE_H
}

constexpr int NWAVES = 8;
constexpr int BATCH = 4, SEQ = 2048, DM = 4096, M = BATCH * SEQ;
constexpr int HD = 128, NH_G = 16, WG_ = 2048;
constexpr int IN_COLS = 13392, IN_PAD = 13568, INA = 1280, INB = 12288;
constexpr int C_QA = 0, C_KA = 2048, C_VA = 4096, C_QB = 6144, C_KB = 8192, C_VB = 10240, C_QI = 12288, C_KI = 13312, C_WI = 13376;
constexpr int DFF = 11008, DFF2 = 22016, DFFP = 11264;
constexpr float ALPHA = 1.189207115002721f;
constexpr float LN_EPS = 1e-5f;
static_assert(att::LQ == IN_PAD && att::LO == DM, "attention strides");

constexpr size_t MiB = 1u << 20;
constexpr size_t WS_CTL = 0, CTL_ZERO_BYTES = 1 * MiB;
constexpr size_t WS_WIN = 1 * MiB;
constexpr size_t WS_WV = WS_WIN + 42 * MiB;
constexpr size_t WS_WOUT = WS_WIN + 106 * MiB;
constexpr size_t WS_WUP = WS_WOUT + 32 * MiB;
constexpr size_t WS_WDN = WS_WUP + 86 * MiB;
constexpr size_t WS_XH = WS_WDN + 43 * MiB;
constexpr size_t WS_PROJ = WS_XH + 64 * MiB;
constexpr size_t WS_Y = WS_PROJ + 212 * MiB;
constexpr size_t WS_MW = WS_Y + 64 * MiB;
constexpr size_t WS_M8 = WS_MW + 2 * MiB;
constexpr size_t WS_KBAR = WS_M8 + 512 * 1024;
constexpr size_t WS_STATS = WS_M8 + 768 * 1024;
constexpr size_t WS_SSQ = WS_M8 + 832 * 1024;
constexpr size_t WS_Z = WS_M8 + 1 * MiB;
constexpr size_t WS_X1Q = WS_Z + 128 * MiB;
constexpr size_t WS_U = WS_X1Q + 32 * MiB;
constexpr size_t WS_END = WS_U + 344 * MiB;
constexpr size_t WS_H = WS_PROJ;
static_assert((size_t)IN_PAD * DM * 2 == 106 * MiB && (size_t)DFF2 * DM == 86 * MiB && (size_t)DM * DFF == 43 * MiB && (size_t)M * IN_PAD * 2 == 212 * MiB && (size_t)M * DFF2 * 2 == 344 * MiB, "ws map");
constexpr float SC_Y = 16.f, SC_WO = 2048.f, SC_U = 32.f, SC_XQ = 16.f, SC_WV = 1024.f, FP8_MAX = 240.f;
constexpr float SC_H = 5.0f, SC_WDN = 2.0f / (0.0095311f * 0.5946035575f);
constexpr float SC_X1 = 2.0f, SC_WUP = 2.0f / (0.015625f * 0.5946035575f);
constexpr int CW_BAR = 4096;

constexpr int SCR_BYTES = 151552;
constexpr int LDSCTL_OFF = SCR_BYTES, MISC_OFF = LDSCTL_OFF + 320;
constexpr int LDS_BYTES = SCR_BYTES + 1024;
static_assert(att::ATT_LDS_BYTES <= SCR_BYTES && pg8::STAGE_BYTES <= SCR_BYTES, "LDS map");

#define GAS __attribute__((address_space(1)))
#define LAS __attribute__((address_space(3)))
typedef _Float16 f16;
typedef _Float16 h8 __attribute__((ext_vector_type(8)));
typedef unsigned v4u __attribute__((ext_vector_type(4)));
typedef float f32x4 __attribute__((ext_vector_type(4)));
typedef GAS unsigned gu32;
#define RLX_AGENT __ATOMIC_RELAXED, __HIP_MEMORY_SCOPE_AGENT
#define LDS_WAIT() asm volatile("s_waitcnt lgkmcnt(0)" ::: "memory")
#define VM_WAIT() asm volatile("s_waitcnt vmcnt(0)" ::: "memory")

#define XB_TMO      128
#define XB_XCNT(j)  (256  + 64 * (j))
#define XB_XSUB(j)  (1280 + 64 * (j))
#define XB_XGEN(j)  (2304 + 64 * (j))
#define XB_TOP      3328
#define XB_TOPGEN   3392
#define XCD_BAR_WORDS 3456
#define XB_SPIN_CAP (1u << 18)

__device__ __forceinline__ unsigned xb_ld(unsigned* p)              { return __hip_atomic_load(p, __ATOMIC_RELAXED, __HIP_MEMORY_SCOPE_AGENT); }
__device__ __forceinline__ unsigned xb_add(unsigned* p, unsigned v) { return __hip_atomic_fetch_add(p, v, __ATOMIC_RELAXED, __HIP_MEMORY_SCOPE_AGENT); }
__device__ __forceinline__ unsigned xb_xcc_id() { return (unsigned)__builtin_amdgcn_s_getreg((3 << 11) | 20) & 0xFu; }
#define XB_SPIN(cond, bar) do { unsigned _sp = 0; while (cond) { __builtin_amdgcn_s_sleep(1); \
    if ((++_sp & 255u) == 0u) { if (xb_ld(&(bar)[XB_TMO])) break; if (_sp > XB_SPIN_CAP) { atomicAdd(&(bar)[XB_TMO], 1u); break; } } } } while (0)

struct XcdBarrier {
    unsigned* bar; unsigned x;
    volatile LAS unsigned* st;
};

__device__ __forceinline__ XcdBarrier xcd_barrier_post(unsigned* bar, volatile LAS unsigned* st) {
    XcdBarrier b; b.bar = bar; b.x = xb_xcc_id(); b.st = st;
    if (threadIdx.x == 0) (void)xb_add(&bar[XB_XCNT(b.x)], 1u);
    return b;
}
__device__ __forceinline__ void xcd_barrier_complete(unsigned* bar, unsigned x, unsigned& nloc, unsigned& nx) {
    const unsigned G = gridDim.x * gridDim.y * gridDim.z;
    unsigned sum, cnt, mine, sp = 0u;
    for (;;) {
        sum = 0u; cnt = 0u; mine = 0u;
#pragma unroll
        for (unsigned j = 0; j < 16; ++j) { const unsigned c = xb_ld(&bar[XB_XCNT(j)]); sum += c; cnt += (c > 0u) ? 1u : 0u; mine = (j == x) ? c : mine; }
        if (sum == G) break;
        __builtin_amdgcn_s_sleep(1);
        if ((++sp & 255u) == 0u) { if (xb_ld(&bar[XB_TMO])) break; if (sp > XB_SPIN_CAP) { atomicAdd(&bar[XB_TMO], 1u); break; } }
    }
    nloc = mine > 0u ? mine : 1u; nx = cnt > 0u ? cnt : 1u;
}

__device__ __forceinline__ void xcd_barrier(const XcdBarrier& b) {
    asm volatile("s_waitcnt vmcnt(0)" ::: "memory");
    __syncthreads();
    if (threadIdx.x == 0) {
        unsigned* bar = b.bar;
        __builtin_amdgcn_s_waitcnt(0);
        unsigned nloc = b.st[0], nx = b.st[1];
        if (nloc == 0u) { xcd_barrier_complete(bar, b.x, nloc, nx); b.st[0] = nloc; b.st[1] = nx; }
        const unsigned old = xb_add(&bar[XB_XSUB(b.x)], 1u);
        const unsigned gen = old / nloc;
        if (old + 1u == (gen + 1u) * nloc) {
            __builtin_amdgcn_fence(__ATOMIC_RELEASE, "agent");
            asm volatile("s_waitcnt vmcnt(0)" ::: "memory");
            const unsigned og = xb_add(&bar[XB_TOP], 1u);
            const unsigned tg = og / nx;
            if (og + 1u == (tg + 1u) * nx) xb_add(&bar[XB_TOPGEN], 1u);
            else XB_SPIN(xb_ld(&bar[XB_TOPGEN]) == tg, bar);
            __builtin_amdgcn_fence(__ATOMIC_ACQUIRE, "agent");
            xb_add(&bar[XB_XGEN(b.x)], 1u);
            asm volatile("s_waitcnt vmcnt(0)" ::: "memory");
        } else {
            XB_SPIN(xb_ld(&bar[XB_XGEN(b.x)]) == gen, bar);
            __builtin_amdgcn_fence(__ATOMIC_ACQUIRE, "agent");
            asm volatile("s_waitcnt vmcnt(0)" ::: "memory");
        }
    }
    __syncthreads();
}


struct Frame {
    LAS unsigned char* lds;
    volatile LAS unsigned* MISC;
    gu32* ctl;
    int tid, lane, wave;
    int vcu, G;
};
__device__ __forceinline__ float wave_sum(float v) {
#pragma unroll
    for (int o = 1; o < 64; o <<= 1) v += __shfl_xor(v, o);
    return v;
}
__device__ __forceinline__ int wave_isum(int v) {
    int t = 0;
#pragma unroll
    for (int b = 0; b < 6; ++b) t += __builtin_popcountll(__ballot((v >> b) & 1)) << b;
    return t;
}
__device__ __forceinline__ unsigned pk2h(float lo, float hi) { return pg8::cvt_pk_f16(lo, hi); }

__device__ __forceinline__ void p0_tr_item(const float* W, int K, int N, f16* WT, const float* gain, LAS float* scr, int k0, int n0s, int n0, int lane) {
    const int kk = lane >> 4, c4 = (lane & 15) * 4;
    const bool inb = (n0s + c4) < N;
    f32x4 v[16];
#pragma unroll
    for (int i = 0; i < 16; ++i) v[i] = inb ? *(const f32x4*)(W + (size_t)(k0 + 4 * i + kk) * N + n0s + c4) : (f32x4){0.f, 0.f, 0.f, 0.f};
#pragma unroll
    for (int i = 0; i < 16; ++i) { const int k = 4 * i + kk; const float g = gain ? gain[k0 + k] : 1.f; LAS float* s = scr + k * 65 + c4;
        s[0] = v[i].x * g; s[1] = v[i].y * g; s[2] = v[i].z * g; s[3] = v[i].w * g; }
    LDS_WAIT(); asm volatile("" ::: "memory");
    const int c = lane & 7, nl = lane >> 3;
#pragma unroll
    for (int j = 0; j < 8; ++j) { const int n = nl + 8 * j; const LAS float* s = scr + (8 * c) * 65 + n;
        v4u o; o.x = pk2h(s[0 * 65], s[1 * 65]); o.y = pk2h(s[2 * 65], s[3 * 65]); o.z = pk2h(s[4 * 65], s[5 * 65]); o.w = pk2h(s[6 * 65], s[7 * 65]);
        *(GAS v4u*)(WT + (size_t)(n0 + n) * K + k0 + 8 * c) = o; }
    LDS_WAIT(); asm volatile("" ::: "memory");
}
__device__ __forceinline__ unsigned pk4_fp8(float a, float b, float c, float d) {
    a = __builtin_fminf(__builtin_fmaxf(a, -FP8_MAX), FP8_MAX); b = __builtin_fminf(__builtin_fmaxf(b, -FP8_MAX), FP8_MAX);
    c = __builtin_fminf(__builtin_fmaxf(c, -FP8_MAX), FP8_MAX); d = __builtin_fminf(__builtin_fmaxf(d, -FP8_MAX), FP8_MAX);
    int w = __builtin_amdgcn_cvt_pk_fp8_f32(a, b, 0, false); w = __builtin_amdgcn_cvt_pk_fp8_f32(c, d, w, true); return (unsigned)w; }
__device__ __forceinline__ unsigned pk8_fp4(float a, float b, float c, float d, float e, float f, float g, float h) {
    unsigned w = 0u;
    w = __builtin_amdgcn_cvt_scalef32_pk_fp4_f32(w, a, b, 1.0f, 0); w = __builtin_amdgcn_cvt_scalef32_pk_fp4_f32(w, c, d, 1.0f, 1);
    w = __builtin_amdgcn_cvt_scalef32_pk_fp4_f32(w, e, f, 1.0f, 2); w = __builtin_amdgcn_cvt_scalef32_pk_fp4_f32(w, g, h, 1.0f, 3); return w; }
__device__ __forceinline__ void p0_tr4_item(const float* W, int Kv, int K, int N, unsigned char* WT, float scale, LAS float* scr, int item, int lane) {
    typedef unsigned v2u __attribute__((ext_vector_type(2)));
    const int nblk = N / 32, kb = item / nblk, nb = item - kb * nblk, k0 = 128 * kb, n0 = 32 * nb;
    const int kk = lane >> 3, c4 = (lane & 7) * 4;
    f32x4 v[16];
#pragma unroll
    for (int i = 0; i < 16; ++i) v[i] = (k0 + 8 * i + kk < Kv) ? *(const f32x4*)(W + (size_t)(k0 + 8 * i + kk) * N + n0 + c4) : (f32x4){0.f, 0.f, 0.f, 0.f};
#pragma unroll
    for (int i = 0; i < 16; ++i) { LAS float* s = scr + (8 * i + kk) * 33 + c4; s[0] = v[i].x * scale; s[1] = v[i].y * scale; s[2] = v[i].z * scale; s[3] = v[i].w * scale; }
    LDS_WAIT(); asm volatile("" ::: "memory");
    const int c = lane & 7, nl = lane >> 3;
#pragma unroll
    for (int j = 0; j < 4; ++j) { const int n = nl + 8 * j; const LAS float* s = scr + (16 * c) * 33 + n;
        v2u o; o.x = pk8_fp4(s[0 * 33], s[1 * 33], s[2 * 33], s[3 * 33], s[4 * 33], s[5 * 33], s[6 * 33], s[7 * 33]);
        o.y = pk8_fp4(s[8 * 33], s[9 * 33], s[10 * 33], s[11 * 33], s[12 * 33], s[13 * 33], s[14 * 33], s[15 * 33]);
        *(GAS v2u*)(WT + (size_t)(n0 + n) * (K / 2) + (k0 + 16 * c) / 2) = o; }
    LDS_WAIT(); asm volatile("" ::: "memory");
}
__device__ __forceinline__ void p0_tr8_item(const float* W, int K, int N, unsigned char* WT, float scale, const float* gain, LAS float* scr, int k0, int n0s, int n0, int lane) {
    const int kk = lane >> 3, c4 = (lane & 7) * 4;
    f32x4 v[16];
#pragma unroll
    for (int i = 0; i < 16; ++i) v[i] = *(const f32x4*)(W + (size_t)(k0 + 8 * i + kk) * N + n0s + c4);
#pragma unroll
    for (int i = 0; i < 16; ++i) { LAS float* s = scr + (8 * i + kk) * 33 + c4; const float sg = gain ? scale * gain[k0 + 8 * i + kk] : scale;
        s[0] = v[i].x * sg; s[1] = v[i].y * sg; s[2] = v[i].z * sg; s[3] = v[i].w * sg; }
    LDS_WAIT(); asm volatile("" ::: "memory");
    const int c = lane & 7, nl = lane >> 3;
#pragma unroll
    for (int j = 0; j < 4; ++j) { const int n = nl + 8 * j; const LAS float* s = scr + (16 * c) * 33 + n;
        v4u o; o.x = pk4_fp8(s[0 * 33], s[1 * 33], s[2 * 33], s[3 * 33]); o.y = pk4_fp8(s[4 * 33], s[5 * 33], s[6 * 33], s[7 * 33]);
        o.z = pk4_fp8(s[8 * 33], s[9 * 33], s[10 * 33], s[11 * 33]); o.w = pk4_fp8(s[12 * 33], s[13 * 33], s[14 * 33], s[15 * 33]);
        *(GAS v4u*)(WT + (size_t)(n0 + n) * K + k0 + 16 * c) = o; }
    LDS_WAIT(); asm volatile("" ::: "memory");
}
struct P0Args { const float *x, *w_in, *w_out, *w_up, *w_down, *g_moba, *g_dsa; f16 *win_t; unsigned char *wv_t, *wout_t, *wup_t, *wdn_t; f16 *xh; unsigned char* xq; float* kbar; float* ssq; };
constexpr int P0_LD = 132;
static_assert(256 * P0_LD * 4 <= SCR_BYTES, "P0 tile fits");
struct P0Tile { const float* W; unsigned char* WT; int N, Kv, Nv, k0, n0s, n0d, fmt, rbd; float scale; };
__device__ __forceinline__ P0Tile p0_decode(const P0Args& a, int t) {
    constexpr int T_IN = (DM / 256) * (INA / 128), T_V = (DM / 256) * (INB / 128), T_OUT = (DM / 256) * (DM / 128), T_UP = (DM / 256) * (DFF2 / 128);
    P0Tile d;
    if (t < T_IN) { const int kb = t / (INA / 128), n0 = 128 * (t - kb * (INA / 128));
        d.W = a.w_in; d.WT = (unsigned char*)a.win_t; d.N = IN_COLS; d.Kv = DM; d.Nv = IN_COLS; d.k0 = 256 * kb; d.n0s = C_QI + n0; d.n0d = n0; d.fmt = 16; d.rbd = DM * 2; d.scale = 1.f; return d; }
    t -= T_IN;
    if (t < T_V) { const int kb = t / (INB / 128), n0 = 128 * (t - kb * (INB / 128));
        d.W = a.w_in; d.WT = a.wv_t; d.N = IN_COLS; d.Kv = DM; d.Nv = IN_COLS; d.k0 = 256 * kb; d.n0s = n0; d.n0d = n0; d.fmt = 8; d.rbd = DM; d.scale = SC_WV; return d; }
    t -= T_V;
    if (t < T_OUT) { const int kb = t / (DM / 128), n0 = 128 * (t - kb * (DM / 128));
        d.W = a.w_out; d.WT = a.wout_t; d.N = DM; d.Kv = DM; d.Nv = DM; d.k0 = 256 * kb; d.n0s = n0; d.n0d = n0; d.fmt = 8; d.rbd = DM; d.scale = SC_WO; return d; }
    t -= T_OUT;
    if (t < T_UP) { const int kb = t / (DFF2 / 128), dt = t - kb * (DFF2 / 128), n0 = 128 * dt;
        d.W = a.w_up; d.WT = a.wup_t; d.N = DFF2; d.Kv = DM; d.Nv = DFF2; d.k0 = 256 * kb; d.n0s = (dt & 1) * DFF + 128 * (dt >> 1); d.n0d = n0; d.fmt = 4; d.rbd = DM / 2; d.scale = SC_WUP; return d; }
    t -= T_UP;
    { const int kb = t / (DM / 128), n0 = 128 * (t - kb * (DM / 128));
      d.W = a.w_down; d.WT = a.wdn_t; d.N = DM; d.Kv = DFF; d.Nv = DM; d.k0 = 256 * kb; d.n0s = n0; d.n0d = n0; d.fmt = 4; d.rbd = DFFP / 2; d.scale = SC_WDN; return d; }
}
__device__ __forceinline__ void p0_tile_issue(f32x4 (&v)[16], const P0Tile& d, int) { const int tid = att::fresh_tid();
    const int n0c = d.n0s < d.Nv ? d.n0s : 0;
    const int c4 = (tid & 31) * 4, colc = n0c + c4 < d.Nv ? c4 : d.Nv - 4 - n0c;
    const unsigned voff = (unsigned)((tid >> 5) * d.N + colc) * 4u;
    const int k0c = d.k0 < d.Kv ? d.k0 : 0;
#pragma unroll
    for (int i = 0; i < 16; ++i) { const float* base = d.W + (size_t)(k0c + 16 * i) * d.N + n0c;
#if defined(__HIP_DEVICE_COMPILE__)
        asm volatile("s_nop 4\n\tglobal_load_dwordx4 %0, %1, %2" : "=v"(v[i]) : "v"(voff), "s"(base) : "memory");
#else
        v[i] = *(const f32x4*)(base + voff / 4);
#endif
    }
}
__device__ __forceinline__ void p0_tile_wait(f32x4 (&v)[16], int behind) {
#if defined(__HIP_DEVICE_COMPILE__)
#define P0_ALLV "+v"(v[0]), "+v"(v[1]), "+v"(v[2]), "+v"(v[3]), "+v"(v[4]), "+v"(v[5]), "+v"(v[6]), "+v"(v[7]), "+v"(v[8]), "+v"(v[9]), "+v"(v[10]), "+v"(v[11]), "+v"(v[12]), "+v"(v[13]), "+v"(v[14]), "+v"(v[15])
    if (behind == 16) asm volatile("s_waitcnt vmcnt(8)" : P0_ALLV :: "memory"); else if (behind == 8) asm volatile("s_waitcnt vmcnt(4)" : P0_ALLV :: "memory");
    else if (behind == 4) asm volatile("s_waitcnt vmcnt(2)" : P0_ALLV :: "memory"); else asm volatile("s_waitcnt vmcnt(0)" : P0_ALLV :: "memory");
#undef P0_ALLV
#endif
}
__device__ __forceinline__ void p0_tile_to_lds(const f32x4 (&v)[16], const P0Tile& d, LAS float* scr, int) { const int tid = att::fresh_tid();
    const int c4 = (tid & 31) * 4, kr = tid >> 5; const bool cin = d.n0s + c4 < d.Nv;
#pragma unroll
    for (int i = 0; i < 16; ++i) { const float sg = (cin && d.k0 + kr + 16 * i < d.Kv) ? d.scale : 0.f; *(LAS f32x4*)(scr + (kr + 16 * i) * P0_LD + c4) = v[i] * sg; }
}
__device__ __forceinline__ void p0_tile_store(const P0Tile& d, const LAS float* scr, int) { const int tid = att::fresh_tid();
    const int n = tid & 127, q = tid >> 7; const LAS float* s = scr + (64 * q) * P0_LD + n;
    unsigned char* dst = d.WT + (size_t)(d.n0d + n) * d.rbd;
    if (d.fmt == 16) { GAS v4u* o = (GAS v4u*)(dst + (size_t)(d.k0 + 64 * q) * 2);
#pragma unroll
        for (int j = 0; j < 8; ++j) { v4u w; w.x = pk2h(s[(8 * j + 0) * P0_LD], s[(8 * j + 1) * P0_LD]); w.y = pk2h(s[(8 * j + 2) * P0_LD], s[(8 * j + 3) * P0_LD]);
            w.z = pk2h(s[(8 * j + 4) * P0_LD], s[(8 * j + 5) * P0_LD]); w.w = pk2h(s[(8 * j + 6) * P0_LD], s[(8 * j + 7) * P0_LD]); o[j] = w; __builtin_amdgcn_sched_barrier(0); } }
    else if (d.fmt == 8) { GAS v4u* o = (GAS v4u*)(dst + (size_t)(d.k0 + 64 * q));
#pragma unroll
        for (int j = 0; j < 4; ++j) { v4u w;
            w.x = pk4_fp8(s[(16 * j + 0) * P0_LD], s[(16 * j + 1) * P0_LD], s[(16 * j + 2) * P0_LD], s[(16 * j + 3) * P0_LD]); w.y = pk4_fp8(s[(16 * j + 4) * P0_LD], s[(16 * j + 5) * P0_LD], s[(16 * j + 6) * P0_LD], s[(16 * j + 7) * P0_LD]);
            w.z = pk4_fp8(s[(16 * j + 8) * P0_LD], s[(16 * j + 9) * P0_LD], s[(16 * j + 10) * P0_LD], s[(16 * j + 11) * P0_LD]); w.w = pk4_fp8(s[(16 * j + 12) * P0_LD], s[(16 * j + 13) * P0_LD], s[(16 * j + 14) * P0_LD], s[(16 * j + 15) * P0_LD]); o[j] = w; __builtin_amdgcn_sched_barrier(0); } }
    else { GAS v4u* o = (GAS v4u*)(dst + (size_t)(d.k0 + 64 * q) / 2);
#pragma unroll
        for (int j = 0; j < 2; ++j) { v4u w;
#define P8_(b_) pk8_fp4(s[(32 * j + b_ + 0) * P0_LD], s[(32 * j + b_ + 1) * P0_LD], s[(32 * j + b_ + 2) * P0_LD], s[(32 * j + b_ + 3) * P0_LD], s[(32 * j + b_ + 4) * P0_LD], s[(32 * j + b_ + 5) * P0_LD], s[(32 * j + b_ + 6) * P0_LD], s[(32 * j + b_ + 7) * P0_LD])
            w.x = P8_(0); __builtin_amdgcn_sched_barrier(0); w.y = P8_(8); __builtin_amdgcn_sched_barrier(0); w.z = P8_(16); __builtin_amdgcn_sched_barrier(0); w.w = P8_(24); o[j] = w; __builtin_amdgcn_sched_barrier(0); }
#undef P8_
    }
}
constexpr int P0_NTILES = (DM / 256) * (INA / 128) + (DM / 256) * (INB / 128) + (DM / 256) * (DM / 128) + (DM / 256) * (DFF2 / 128) + (DFFP / 256) * (DM / 128);
constexpr int P0_DEFER_WGS0 = 160, P0_IDLE8_WGS0 = 192;
constexpr int P0_TF16 = (DM / 256) * (INA / 128), P0_T4LO = P0_TF16 + (DM / 256) * (INB / 128), P0_T2LO = P0_NTILES, P0_T3LO = P0_T2LO - 416;
static_assert(P0_T3LO >= P0_NTILES - (DFFP / 256) * (DM / 128), "the tiles converted during the up projection must be w_down tiles");
__device__ __forceinline__ void p0_tile_loop(Frame& F, const P0Args& a, int t0, int tend, int stride) {
    LAS float* scr = (LAS float*)F.lds;
    f32x4 vA[16], vB[16];
    int t = t0;
    if (t < tend) { P0Tile dA = p0_decode(a, t); p0_tile_issue(vA, dA, F.tid); p0_tile_wait(vA, 0);
        for (;;) {
            const int t1 = t + stride; const bool h1 = t1 < tend; const P0Tile dB = p0_decode(a, h1 ? t1 : t);
            p0_tile_issue(vB, dB, F.tid);
            p0_tile_to_lds(vA, dA, scr, F.tid); LDS_WAIT(); __syncthreads();
            p0_tile_store(dA, scr, F.tid); LDS_WAIT(); __syncthreads();
            p0_tile_wait(vB, dA.fmt);
            if (!h1) break;
            const int t2 = t1 + stride; const bool h2 = t2 < tend; dA = p0_decode(a, h2 ? t2 : t1);
            p0_tile_issue(vA, dA, F.tid);
            p0_tile_to_lds(vB, dB, scr, F.tid); LDS_WAIT(); __syncthreads();
            p0_tile_store(dB, scr, F.tid); LDS_WAIT(); __syncthreads();
            p0_tile_wait(vA, dB.fmt);
            if (!h2) break;
            t = t2;
        }
    }
}
__device__ __forceinline__ void p0_prologue(Frame& F, const P0Args& a) {
    { const size_t gt = (size_t)F.vcu * (NWAVES * 64) + F.tid, NT = (size_t)F.G * NWAVES * 64, TOT = (size_t)M * DM, STEP = NT * 8 * 4; typedef unsigned v2u __attribute__((ext_vector_type(2)));
      f32x4 pA[4], qA[4], pB[4], qB[4];
#define P0X_LOAD(p_, q_, i0_) do { _Pragma("unroll") for (int c = 0; c < 4; ++c) { const size_t i = (i0_) + (size_t)c * NT * 8; const size_t ic = i < TOT ? i : gt * 8; p_[c] = *(const f32x4*)(a.x + ic); q_[c] = *(const f32x4*)(a.x + ic + 4); } } while (0)
#define P0X_STORE(p_, q_, i0_) do { _Pragma("unroll") for (int c = 0; c < 4; ++c) { const size_t i = (i0_) + (size_t)c * NT * 8; if (i < TOT) { \
            v4u o; o.x = pk2h(p_[c].x, p_[c].y); o.y = pk2h(p_[c].z, p_[c].w); o.z = pk2h(q_[c].x, q_[c].y); o.w = pk2h(q_[c].z, q_[c].w); *(GAS v4u*)(a.xh + i) = o; \
            v2u oq; oq.x = pk4_fp8(p_[c].x * SC_XQ, p_[c].y * SC_XQ, p_[c].z * SC_XQ, p_[c].w * SC_XQ); oq.y = pk4_fp8(q_[c].x * SC_XQ, q_[c].y * SC_XQ, q_[c].z * SC_XQ, q_[c].w * SC_XQ); \
            *(GAS v2u*)(a.xq + i) = oq; } } } while (0)
      size_t i0 = gt * 8;
      P0X_LOAD(pA, qA, i0);
      for (; i0 < TOT; i0 += 2 * STEP) {
          P0X_LOAD(pB, qB, i0 + STEP);
          P0X_STORE(pA, qA, i0);
          P0X_LOAD(pA, qA, i0 + 2 * STEP);
          P0X_STORE(pB, qB, i0 + STEP);
      }
#undef P0X_LOAD
#undef P0X_STORE
    }
    for (int i = F.vcu * (NWAVES * 64) + F.tid; i < BATCH * 16 * 8 * 128; i += F.G * NWAVES * 64) a.kbar[i] = 0.f;
    for (int i = F.vcu * (NWAVES * 64) + F.tid; i < 2 * M; i += F.G * NWAVES * 64) a.ssq[i] = 0.f;
    p0_tile_loop(F, a, F.vcu, F.G == 256 ? P0_TF16 : P0_NTILES, F.G);
}

__device__ __forceinline__ void kbar_item(const f16* proj, float* kbar, int item, LAS float* scr, int tid) {
    const int n = item & 7, hh = (item >> 3) & 15, b = item >> 7;
    const int r = tid >> 4, c = (tid & 15) * 8;
    const f16* base = proj + (size_t)(b * SEQ + n * 256) * IN_PAD + C_KA + hh * HD + c;
    float s[8];
#pragma unroll
    for (int e = 0; e < 8; ++e) s[e] = 0.f;
#pragma unroll
    for (int j = 0; j < 8; ++j) { const h8 v = *(const h8*)(base + (size_t)(r + 32 * j) * IN_PAD);
#pragma unroll
        for (int e = 0; e < 8; ++e) s[e] += (float)v[e]; }
#pragma unroll
    for (int e = 0; e < 8; ++e) scr[r * 128 + c + e] = s[e];
    __syncthreads();
    if (tid < 128) { float t = 0.f;
#pragma unroll 8
        for (int r2 = 0; r2 < 32; ++r2) t += scr[r2 * 128 + tid];
        kbar[(size_t)item * 128 + tid] = t * (1.f / 256.f); }
    __syncthreads();
}

__device__ __forceinline__ void select_row(const LAS float* srow, int t, unsigned long long* outw, int lane) {
    unsigned long long myw = 0ull;
    if (t < 256) {
        const int lo = 64 * lane;
        myw = (lo + 63 <= t) ? ~0ull : (lo > t ? 0ull : ((1ull << (t - lo + 1)) - 1ull));
    } else {
        unsigned u[32];
#pragma unroll
        for (int i = 0; i < 32; ++i) { const int s = 64 * i + lane; const unsigned bts = __float_as_uint(srow[s]); const unsigned key = bts ^ ((bts >> 31) ? 0xffffffffu : 0x80000000u); u[i] = (s <= t) ? key : 0u; }
        const int ng = (t >> 8) + 1;
        unsigned T = 0u; bool exact = false;
        for (int bit = 31; bit >= 0; --bit) {
            const unsigned cand = T | (1u << bit); int c0 = 0, c1 = 0, c2 = 0, c3 = 0;
#if defined(__HIP_DEVICE_COMPILE__)
#define CNT4(cc, i0) do { unsigned long long m0_, m1_, m2_, m3_; asm volatile( \
                "v_cmp_ge_u32_e64 %1, %5, %9\n\tv_cmp_ge_u32_e64 %2, %6, %9\n\tv_cmp_ge_u32_e64 %3, %7, %9\n\tv_cmp_ge_u32_e64 %4, %8, %9\n\t" \
                "v_addc_co_u32_e64 %0, vcc, 0, %0, %1\n\tv_addc_co_u32_e64 %0, vcc, 0, %0, %2\n\tv_addc_co_u32_e64 %0, vcc, 0, %0, %3\n\tv_addc_co_u32_e64 %0, vcc, 0, %0, %4" \
                : "+v"(cc), "=&s"(m0_), "=&s"(m1_), "=&s"(m2_), "=&s"(m3_) : "v"(u[i0]), "v"(u[i0 + 1]), "v"(u[i0 + 2]), "v"(u[i0 + 3]), "v"(cand) : "vcc"); } while (0)
            CNT4(c0, 0); CNT4(c1, 4); if (ng > 2) CNT4(c2, 8); if (ng > 3) CNT4(c3, 12); if (ng > 4) CNT4(c0, 16); if (ng > 5) CNT4(c1, 20); if (ng > 6) CNT4(c2, 24); if (ng > 7) CNT4(c3, 28);
#undef CNT4
#endif
            const int c = (c0 + c1) + (c2 + c3);
            const int cnt = wave_isum(c);
            if (cnt >= 256) T = cand;
            if (cnt == 256) { exact = true; break; }
        }
        if (exact) {
#pragma unroll
            for (int i = 0; i < 32; ++i) if (i < 4 * ng) { const unsigned long long w = __ballot(u[i] >= T); if (lane == i) myw = w; }
        } else {
        int gtl = 0;
#pragma unroll
        for (int i = 0; i < 32; ++i) gtl += (u[i] > T) ? 1 : 0;
        const int need = 256 - wave_isum(gtl); int run = 0;
#pragma unroll
        for (int i = 0; i < 32; ++i) { const bool tie = (u[i] == T); const unsigned long long tb = __ballot(tie);
            const int below = (int)__builtin_amdgcn_mbcnt_hi((unsigned)(tb >> 32), __builtin_amdgcn_mbcnt_lo((unsigned)tb, 0u));
            const bool sel = (u[i] > T) || (tie && (run + below < need));
            const unsigned long long w = __ballot(sel); run += __builtin_popcountll(tb); if (lane == i) myw = w; }
        }
    }
    if (lane < 32) outw[lane] = myw;
}
__device__ __forceinline__ int cnt4s(int cnt, unsigned k0, unsigned k1, unsigned k2, unsigned k3, unsigned cand) {
#if defined(__HIP_DEVICE_COMPILE__)
    unsigned long long m0_, m1_, m2_, m3_; int t0_, t1_, t2_, t3_;
    asm("v_cmp_ge_u32_e64 %1, %9, %13\n\tv_cmp_ge_u32_e64 %2, %10, %13\n\tv_cmp_ge_u32_e64 %3, %11, %13\n\tv_cmp_ge_u32_e64 %4, %12, %13\n\t"
        "s_bcnt1_i32_b64 %5, %1\n\ts_bcnt1_i32_b64 %6, %2\n\ts_bcnt1_i32_b64 %7, %3\n\ts_bcnt1_i32_b64 %8, %4\n\t"
        "s_add_i32 %5, %5, %6\n\ts_add_i32 %7, %7, %8\n\ts_add_i32 %0, %0, %5\n\ts_add_i32 %0, %0, %7"
        : "+s"(cnt), "=&s"(m0_), "=&s"(m1_), "=&s"(m2_), "=&s"(m3_), "=&s"(t0_), "=&s"(t1_), "=&s"(t2_), "=&s"(t3_) : "v"(k0), "v"(k1), "v"(k2), "v"(k3), "s"(cand) : "scc");
#endif
    return cnt;
}
template <int NG> __device__ __forceinline__ void bisect2(const unsigned (&ua)[32], const unsigned (&ub)[32], unsigned& TA, unsigned& TB, bool& ea, bool& eb) {
    unsigned ta = 0u, tb = 0u; bool xa = false, xb = false;
#pragma unroll 1
    for (int bit = 31; bit >= 0; --bit) {
        const unsigned ca = ta | (1u << bit), cb = tb | (1u << bit); int na = 0, nb = 0;
#pragma unroll
        for (int g = 0; g < NG; ++g) { na = cnt4s(na, ua[4 * g], ua[4 * g + 1], ua[4 * g + 2], ua[4 * g + 3], ca); nb = cnt4s(nb, ub[4 * g], ub[4 * g + 1], ub[4 * g + 2], ub[4 * g + 3], cb); }
        if (na >= 256) ta = ca;
        if (nb >= 256) tb = cb;
        xa = xa || (na == 256); xb = xb || (nb == 256);
        if (xa && xb) break;
    }
    TA = ta; TB = tb; ea = xa; eb = xb;
}
__device__ __forceinline__ unsigned long long select_words(const unsigned (&u)[32], unsigned T, bool exact, int ng, int lane) {
    unsigned long long myw = 0ull;
    asm volatile("" : "+v"(lane));
    if (exact) {
#pragma unroll
        for (int i = 0; i < 32; ++i) if (i < 4 * ng) { const unsigned long long w = __ballot(u[i] >= T); if (lane == i) myw = w; }
    } else {
        int gtl = 0;
#pragma unroll
        for (int i = 0; i < 32; ++i) gtl += (u[i] > T) ? 1 : 0;
        const int need = 256 - wave_isum(gtl); int run = 0;
#pragma unroll
        for (int i = 0; i < 32; ++i) { const bool tie = (u[i] == T); const unsigned long long tb = __ballot(tie);
            const int below = (int)__builtin_amdgcn_mbcnt_hi((unsigned)(tb >> 32), __builtin_amdgcn_mbcnt_lo((unsigned)tb, 0u));
            const bool sel = (u[i] > T) || (tie && (run + below < need));
            const unsigned long long w = __ballot(sel); run += __builtin_popcountll(tb); if (lane == i) myw = w; }
    }
    return myw;
}
__device__ __forceinline__ void select_rows2(const LAS float* srow, int ld, int t, unsigned long long* outw, int lane) {
    asm volatile("" : "+v"(lane));
    if (t < 256) {
#pragma unroll
        for (int r = 0; r < 2; ++r) { const int tt = t + r, lo = 64 * lane;
            const unsigned long long myw = (lo + 63 <= tt) ? ~0ull : (lo > tt ? 0ull : ((1ull << (tt - lo + 1)) - 1ull));
            if (lane < 32) outw[32 * r + lane] = myw; }
        return;
    }
    unsigned ua[32], ub[32];
#pragma unroll
    for (int i = 0; i < 32; ++i) { const int s = 64 * i + lane;
        const unsigned ba = __float_as_uint(srow[s]), bb = __float_as_uint(srow[ld + s]);
        const unsigned ka = ba ^ ((ba >> 31) ? 0xffffffffu : 0x80000000u), kb = bb ^ ((bb >> 31) ? 0xffffffffu : 0x80000000u);
        ua[i] = (s <= t) ? ka : 0u; ub[i] = (s <= t + 1) ? kb : 0u; }
    const int ng = ((t + 1) >> 8) + 1;
    unsigned TA = 0u, TB = 0u; bool ea = false, eb = false;
    switch (ng) {
        case 2: bisect2<2>(ua, ub, TA, TB, ea, eb); break;
        case 3: bisect2<3>(ua, ub, TA, TB, ea, eb); break;
        case 4: bisect2<4>(ua, ub, TA, TB, ea, eb); break;
        case 5: bisect2<5>(ua, ub, TA, TB, ea, eb); break;
        case 6: bisect2<6>(ua, ub, TA, TB, ea, eb); break;
        case 7: bisect2<7>(ua, ub, TA, TB, ea, eb); break;
        default: bisect2<8>(ua, ub, TA, TB, ea, eb); break;
    }
    const unsigned long long wa = select_words(ua, TA, ea, ng, lane), wb = select_words(ub, TB, eb, ng, lane);
    if (lane < 32) { outw[lane] = wa; outw[32 + lane] = wb; }
}
constexpr int SC_LD = 2052;
static_assert(16 * SC_LD * 4 <= SCR_BYTES, "score tile fits");
__device__ __forceinline__ void dsa_index_unit(const f16* proj, unsigned long long* maskw, int b, int tq, LAS unsigned char* lds, int tid) {
    typedef float f4 __attribute__((ext_vector_type(4)));
    tid = att::fresh_tid();
    const int wid = __builtin_amdgcn_readfirstlane(tid >> 6), lane = tid & 63, fr = lane & 15, fq = lane >> 4;
    const int t0 = tq * 16, nkt = tq + 1;
    const f16* qrow = proj + (size_t)(b * SEQ + t0 + fr) * IN_PAD;
    h8 qf[16][2];
#pragma unroll
    for (int h = 0; h < 16; ++h)
#pragma unroll
        for (int kk = 0; kk < 2; ++kk) qf[h][kk] = *(const h8*)(qrow + C_QI + h * 64 + kk * 32 + fq * 8);
    float wv[16];
    { const h8 w0 = *(const h8*)(qrow + C_WI), w1 = *(const h8*)(qrow + C_WI + 8);
#pragma unroll
      for (int h = 0; h < 8; ++h) { wv[h] = (float)w0[h]; wv[8 + h] = (float)w1[h]; } }
    h8 qt[2];
#pragma unroll
    for (int kk = 0; kk < 2; ++kk)
#pragma unroll
        for (int e = 0; e < 8; ++e) { float a = 0.f;
#pragma unroll
            for (int h = 0; h < 16; ++h) a = __builtin_fmaf(wv[h], (float)qf[h][kk][e], a);
            qt[kk][e] = (_Float16)a; }
    LAS float* sc = (LAS float*)lds;
    const f16* kbase = proj + (size_t)(b * SEQ + fr) * IN_PAD + C_KI + fq * 8;
    const f16* kb_ = proj + (size_t)(b * SEQ) * IN_PAD + C_KI;
    const unsigned voffk = (unsigned)(fr * IN_PAD + fq * 8) * 2u;
    h8 kr[3][2];
#if defined(__HIP_DEVICE_COMPILE__)
#define KLD2(d_, kt_) do { const f16* bp_ = kb_ + (size_t)((kt_) * 16) * IN_PAD; \
        asm volatile("s_nop 4\n\tglobal_load_dwordx4 %0, %1, %2" : "=v"(kr[d_][0]) : "v"(voffk), "s"(bp_) : "memory"); \
        asm volatile("global_load_dwordx4 %0, %1, %2 offset:64" : "=v"(kr[d_][1]) : "v"(voffk), "s"(bp_) : "memory"); } while (0)
#define KWAIT(d_, n_) asm volatile("s_waitcnt vmcnt(" #n_ ")" : "+v"(kr[d_][0]), "+v"(kr[d_][1]) :: "memory")
#else
#define KLD2(d_, kt_) do { kr[d_][0] = *(const h8*)(kbase + (size_t)((kt_) * 16) * IN_PAD); kr[d_][1] = *(const h8*)(kbase + (size_t)((kt_) * 16) * IN_PAD + 32); } while (0)
#define KWAIT(d_, n_) do { } while (0)
#endif
#pragma unroll
    for (int d = 0; d < 3; ++d) { const int k_ = (wid + 8 * d < nkt) ? wid + 8 * d : nkt - 1; KLD2(d, k_); }
    for (int kt0 = wid; kt0 < nkt; kt0 += 24) {
#pragma unroll
      for (int d = 0; d < 3; ++d) { const int kt = kt0 + 8 * d;
        if (kt < nkt) {
        KWAIT(d, 4);
        const h8 k0 = kr[d][0], k1 = kr[d][1];
        f4 acc = {0.f, 0.f, 0.f, 0.f};
#define IDX_MM(h_, TA, TB) do { TA = (f4){0.f, 0.f, 0.f, 0.f}; TB = (f4){0.f, 0.f, 0.f, 0.f}; \
            TA = __builtin_amdgcn_mfma_f32_16x16x32_f16(k0, qf[h_][0], TA, 0, 0, 0); TB = __builtin_amdgcn_mfma_f32_16x16x32_f16(k0, qf[(h_) + 1][0], TB, 0, 0, 0); \
            TA = __builtin_amdgcn_mfma_f32_16x16x32_f16(k1, qf[h_][1], TA, 0, 0, 0); TB = __builtin_amdgcn_mfma_f32_16x16x32_f16(k1, qf[(h_) + 1][1], TB, 0, 0, 0); } while (0)
        { f4 ta, tb, na, nb; IDX_MM(0, ta, tb);
#pragma unroll
          for (int h = 0; h < 16; h += 2) {
            if (h + 2 < 16) IDX_MM(h + 2, na, nb);
#pragma unroll
            for (int j = 0; j < 4; ++j) acc[j] = __builtin_fmaf(wv[h], __builtin_fabsf(ta[j]), acc[j]);
#pragma unroll
            for (int j = 0; j < 4; ++j) acc[j] = __builtin_fmaf(wv[h + 1], __builtin_fabsf(tb[j]), acc[j]);
            ta = na; tb = nb; __builtin_amdgcn_sched_barrier(0); } }
#undef IDX_MM
        { f4 tl = {0.f, 0.f, 0.f, 0.f};
          tl = __builtin_amdgcn_mfma_f32_16x16x32_f16(k0, qt[0], tl, 0, 0, 0);
          tl = __builtin_amdgcn_mfma_f32_16x16x32_f16(k1, qt[1], tl, 0, 0, 0);
#pragma unroll
          for (int j = 0; j < 4; ++j) acc[j] += tl[j]; }
        *(LAS f4*)(sc + fr * SC_LD + kt * 16 + 4 * fq) = acc;
        { const int ktn = (kt + 24 < nkt) ? kt + 24 : nkt - 1;
          asm volatile("" : "+v"(acc));
          KLD2(d, ktn); }
        } }
    }
    asm volatile("s_waitcnt vmcnt(0)" : "+v"(kr[0][0]), "+v"(kr[0][1]), "+v"(kr[1][0]), "+v"(kr[1][1]), "+v"(kr[2][0]), "+v"(kr[2][1]) :: "memory");
#undef KLD2
#undef KWAIT
    __syncthreads();
    { const int q = 2 * wid, t = t0 + q;
        select_rows2(sc + q * SC_LD, SC_LD, t, maskw + (size_t)(b * SEQ + t) * 32, lane); }
    __syncthreads();
}

__device__ __forceinline__ void moba_gate_item(const f16* proj, const float* kbar, unsigned char* m8, int item, LAS float* kb, int tid) {
    const int qb = item & 7, hh = (item >> 3) & 15, b = item >> 7;
    tid = att::fresh_tid();
    for (int i = tid; i < qb * 128; i += NWAVES * 64) kb[i] = kbar[(size_t)((b * 16 + hh) * 8) * 128 + i];
    __syncthreads();
    { const int t = qb * 256 + (tid >> 1), hf = tid & 1; const f16* q = proj + (size_t)(b * SEQ + t) * IN_PAD + C_QA + hh * HD + hf * 64;
        float g[7];
#pragma unroll
        for (int n = 0; n < 7; ++n) g[n] = 0.f;
#pragma unroll 4
        for (int c = 0; c < 8; ++c) { const h8 v = *(const h8*)(q + c * 8);
#pragma unroll
            for (int n = 0; n < 7; ++n) if (n < qb) {
#pragma unroll
                for (int e = 0; e < 8; ++e) g[n] += (float)v[e] * kb[n * 128 + hf * 64 + c * 8 + e]; } }
#pragma unroll
        for (int n = 0; n < 7; ++n) g[n] += __uint_as_float((unsigned)__builtin_amdgcn_update_dpp(0, (int)__float_as_uint(g[n]), 0xB1, 0xF, 0xF, true));
        unsigned m = 1u << qb;
        if (qb <= 3) m |= (1u << qb) - 1u;
        else {
#pragma unroll
            for (int pick = 0; pick < 3; ++pick) { float bv = -3.0e38f; int bi = 0;
#pragma unroll
                for (int n = 0; n < 7; ++n) if (n < qb && !((m >> n) & 1u) && g[n] > bv) { bv = g[n]; bi = n; }
                m |= 1u << bi; } }
        if (hf == 0) m8[(size_t)(b * 16 + hh) * SEQ + t] = (unsigned char)m; }
    __syncthreads();
}

__device__ __forceinline__ att::Blk att_ref(int item, int second, unsigned char* YQ, float* SSQ, const float* g_moba, const float* g_dsa, const unsigned long long* MW, const unsigned char* M8) {
    const int dsa = item >> 8, idx = item & 255, b = idx >> 6, hh = (idx >> 2) & 15, p = idx & 3, qb = second ? 7 - p : p;
    att::Blk r; const size_t row0 = (size_t)b * SEQ;
    r.Q = (unsigned)(((row0 + qb * 256) * IN_PAD + (dsa ? C_QB : C_QA) + hh * HD) * 2);
    r.K = (unsigned)((row0 * IN_PAD + (dsa ? C_KB : C_KA) + hh * HD) * 2);
    r.V = (unsigned)((row0 * IN_PAD + (dsa ? C_VB : C_VA) + hh * HD) * 2);
    r.O = YQ + (row0 + qb * 256) * DM + dsa * WG_ + hh * HD; r.SQ = SSQ + 2 * (row0 + qb * 256) + dsa; r.G = (dsa ? g_dsa : g_moba) + hh * HD;
    r.MW = MW + (row0 + qb * 256) * 32;
    r.M8 = M8 + (size_t)(b * 16 + hh) * SEQ + qb * 256;
    r.P0 = qb * 256; r.dsa = dsa; return r;
}
__device__ __forceinline__ float t5_tab_entry(const float* rel, int hg, int dist) {
    if (dist < 0 || dist >= 113) return 0.f;
    int bucket = dist;
    if (dist >= 16) { bucket = 16; const int th[15] = {19, 21, 24, 27, 31, 35, 40, 46, 52, 59, 67, 77, 87, 99, 113};
#pragma unroll
        for (int i = 0; i < 15; ++i) bucket += (dist >= th[i]) ? 1 : 0; }
    return (rel[bucket * 32 + hg] - rel[31 * 32 + hg]) * (1.0f / att::SCALE);
}
__device__ __forceinline__ void attn_phase(Frame& F, char* lds, const f16* proj, unsigned char* YQ, float* SSQ, const float* g_moba, const float* g_dsa, const unsigned long long* MW, const unsigned char* M8, const float* rel) {
    att::Seam S;
    const int items[2] = {F.vcu, 256 + F.vcu};
    const att::rsrc_t RS = __builtin_amdgcn_make_buffer_rsrc((void*)proj, 0, (int)((size_t)M * IN_PAD * 2), 0x00020000);
    att::Blk cur = att_ref(items[0], 0, YQ, SSQ, g_moba, g_dsa, MW, M8);
    att::attn_prime(cur, RS, lds, S);
#pragma unroll 1
    for (int i = 0; i < 4; ++i) {
        const int ni = (i < 3) ? i + 1 : 3;
        const att::Blk nxt = att_ref((ni >> 1) ? items[1] : items[0], ni & 1, YQ, SSQ, g_moba, g_dsa, MW, M8);
        if ((i & 1) == 0) {
            const int item = (i >> 1) ? items[1] : items[0]; const int hg = (item >> 8) * 16 + (((item & 255) >> 2) & 15);
            const int ft = att::fresh_tid();
            ((LAS float*)((LAS char*)lds + att::TAB_OFF))[ft] = t5_tab_entry(rel, hg, ft - 256);
            __syncthreads();
        }
        att::attn_block(cur, nxt, RS, lds, S);
        cur = nxt;
    }
}

__device__ __forceinline__ void rms_rows(Frame& F, const f16* Y, unsigned char* YQ, const float* g_moba, const float* g_dsa) {
    const int gw = F.vcu * NWAVES + F.wave, NGW = F.G * NWAVES;
    f32x4 gg[8][2];
#pragma unroll
    for (int j = 0; j < 8; ++j) { const float* gp = (j < 4 ? g_moba : g_dsa - WG_) + 8 * F.lane + 512 * j; gg[j][0] = *(const f32x4*)gp; gg[j][1] = *(const f32x4*)(gp + 4); }
    for (int m = gw; m < M; m += NGW) { const GAS h8* yr = (const GAS h8*)(Y + (size_t)m * DM) + F.lane;
        h8 v[8]; float sa = 0.f, sb = 0.f;
#pragma unroll
        for (int j = 0; j < 8; ++j) { v[j] = yr[64 * j];
#pragma unroll
            for (int e = 0; e < 8; ++e) { const float f = (float)v[j][e]; if (j < 4) sa += f * f; else sb += f * f; } }
        const float ra = 1.f / sqrtf(wave_sum(sa) * (1.f / WG_) + LN_EPS), rb = 1.f / sqrtf(wave_sum(sb) * (1.f / WG_) + LN_EPS);
#pragma unroll
        for (int j = 0; j < 8; ++j) { const float r = (j < 4 ? ra : rb) * SC_Y; typedef unsigned v2u __attribute__((ext_vector_type(2))); v2u o;
            o.x = pk4_fp8((float)v[j][0] * r * gg[j][0].x, (float)v[j][1] * r * gg[j][0].y, (float)v[j][2] * r * gg[j][0].z, (float)v[j][3] * r * gg[j][0].w);
            o.y = pk4_fp8((float)v[j][4] * r * gg[j][1].x, (float)v[j][5] * r * gg[j][1].y, (float)v[j][6] * r * gg[j][1].z, (float)v[j][7] * r * gg[j][1].w);
            *((GAS v2u*)(YQ + (size_t)m * DM) + F.lane + 64 * j) = o; } }
}
__device__ __forceinline__ void ln_rows(Frame& F, const f16* Z, const float* g, const float* bta, float* outf, unsigned char* outq, float* stats) {
    const int gw = F.vcu * NWAVES + F.wave, NGW = F.G * NWAVES;
    for (int m = gw; m < M; m += NGW) { const GAS h8* zr = (const GAS h8*)(Z + (size_t)m * DM) + F.lane;
        f32x4 v[8][2]; float s = 0.f;
#pragma unroll
        for (int j = 0; j < 8; ++j) { const h8 zz = zr[64 * j];
            v[j][0] = (f32x4){(float)zz[0], (float)zz[1], (float)zz[2], (float)zz[3]}; v[j][1] = (f32x4){(float)zz[4], (float)zz[5], (float)zz[6], (float)zz[7]};
#pragma unroll
            for (int h = 0; h < 2; ++h) s += (v[j][h].x + v[j][h].y) + (v[j][h].z + v[j][h].w); }
        const float mean = wave_sum(s) * (1.f / DM); float s2 = 0.f;
#pragma unroll
        for (int j = 0; j < 8; ++j)
#pragma unroll
            for (int h = 0; h < 2; ++h) { v[j][h] = v[j][h] - mean; s2 += (v[j][h].x * v[j][h].x + v[j][h].y * v[j][h].y) + (v[j][h].z * v[j][h].z + v[j][h].w * v[j][h].w); }
        const float rstd = 1.f / sqrtf(wave_sum(s2) * (1.f / DM) + LN_EPS);
        if (stats && F.lane == 0) { stats[2 * (size_t)m] = mean; stats[2 * (size_t)m + 1] = rstd; }
        GAS f32x4* of = (GAS f32x4*)(outf + (size_t)m * DM) + 2 * F.lane;
#pragma unroll
        for (int j = 0; j < 8; ++j) { f32x4 y[2];
#pragma unroll
            for (int h = 0; h < 2; ++h) { const f32x4 gg = *((const GAS f32x4*)g + 2 * F.lane + 128 * j + h), bb = *((const GAS f32x4*)bta + 2 * F.lane + 128 * j + h);
                y[h] = v[j][h] * rstd * gg + bb; if (outf) of[128 * j + h] = y[h]; }
            if (outq) *((GAS unsigned*)(outq + (size_t)m * (DM / 2)) + F.lane + 64 * j) =
                pk8_fp4(y[0].x * SC_X1, y[0].y * SC_X1, y[0].z * SC_X1, y[0].w * SC_X1, y[1].x * SC_X1, y[1].y * SC_X1, y[1].z * SC_X1, y[1].w * SC_X1); } }
}
__device__ __forceinline__ void conv_gate(Frame& F, const unsigned char* U, const float* cw, const float* cb, unsigned char* H) {
    constexpr int NCC = DFFP / 8, RCH = 32, NRC = SEQ / RCH;
    const size_t gt = (size_t)F.vcu * (NWAVES * 64) + F.tid, NT = (size_t)F.G * NWAVES * 64, NIT = (size_t)BATCH * NRC * NCC;
    for (size_t it = gt; it < NIT; it += NT) {
        const int cc = (int)(it % NCC); const int rc = (int)((it / NCC) % NRC), b = (int)(it / ((size_t)NCC * NRC));
        const int c = cc * 8, r0 = rc * RCH;
        if (c >= DFF) { for (int r = 0; r < RCH; ++r) *(GAS unsigned*)(H + (size_t)(b * SEQ + r0 + r) * (DFFP / 2) + c / 2) = 0u; continue; }
        float w[2][3][8], bs[2][8];
#pragma unroll
        for (int s = 0; s < 2; ++s) {
#pragma unroll
            for (int j = 0; j < 3; ++j) { const f32x4 a = *(const f32x4*)(cw + (size_t)j * DFF2 + s * DFF + c), d = *(const f32x4*)(cw + (size_t)j * DFF2 + s * DFF + c + 4);
                const float iu = 1.f / SC_U;
                w[s][j][0] = a.x * iu; w[s][j][1] = a.y * iu; w[s][j][2] = a.z * iu; w[s][j][3] = a.w * iu; w[s][j][4] = d.x * iu; w[s][j][5] = d.y * iu; w[s][j][6] = d.z * iu; w[s][j][7] = d.w * iu; }
            const f32x4 a = *(const f32x4*)(cb + s * DFF + c), d = *(const f32x4*)(cb + s * DFF + c + 4);
            bs[s][0] = a.x; bs[s][1] = a.y; bs[s][2] = a.z; bs[s][3] = a.w; bs[s][4] = d.x; bs[s][5] = d.y; bs[s][6] = d.z; bs[s][7] = d.w; }
        typedef unsigned v2u __attribute__((ext_vector_type(2))); typedef float f2v __attribute__((ext_vector_type(2)));
        const unsigned char* ub = U + (size_t)(b * SEQ) * DFF2 + c;
#define UNPK8(dst, q) do { const f2v t0_ = __builtin_amdgcn_cvt_pk_f32_fp8((int)(q).x, false), t1_ = __builtin_amdgcn_cvt_pk_f32_fp8((int)(q).x, true), t2_ = __builtin_amdgcn_cvt_pk_f32_fp8((int)(q).y, false), t3_ = __builtin_amdgcn_cvt_pk_f32_fp8((int)(q).y, true); \
        dst[0] = t0_.x; dst[1] = t0_.y; dst[2] = t1_.x; dst[3] = t1_.y; dst[4] = t2_.x; dst[5] = t2_.y; dst[6] = t3_.x; dst[7] = t3_.y; } while (0)
        float p2[2][8], p1[2][8];
#pragma unroll
        for (int s = 0; s < 2; ++s) { v2u a = {0u, 0u}, d = {0u, 0u};
            if (r0 >= 2) { a = *(const v2u*)(ub + (size_t)(r0 - 2) * DFF2 + s * DFF); d = *(const v2u*)(ub + (size_t)(r0 - 1) * DFF2 + s * DFF); }
            UNPK8(p2[s], a); UNPK8(p1[s], d); }
#pragma unroll 8
        for (int r = 0; r < RCH; ++r) { const int t = r0 + r; float o[8];
            float cv[2][8];
#pragma unroll
            for (int s = 0; s < 2; ++s) { const v2u a = *(const v2u*)(ub + (size_t)t * DFF2 + s * DFF); float xa[8]; UNPK8(xa, a);
#pragma unroll
                for (int e = 0; e < 8; ++e) { const float x = xa[e]; cv[s][e] = w[s][0][e] * p2[s][e] + w[s][1][e] * p1[s][e] + w[s][2][e] * x + bs[s][e]; p2[s][e] = p1[s][e]; p1[s][e] = x; } }
#pragma unroll
            for (int e = 0; e < 8; ++e) { const float gte = cv[1][e]; o[e] = cv[0][e] * gte * __builtin_amdgcn_rcpf(1.f + __builtin_amdgcn_exp2f(-1.4426950408889634f * gte)); }
            *(GAS unsigned*)(H + (size_t)(b * SEQ + t) * (DFFP / 2) + c / 2) = pk8_fp4(o[0] * SC_H, o[1] * SC_H, o[2] * SC_H, o[3] * SC_H, o[4] * SC_H, o[5] * SC_H, o[6] * SC_H, o[7] * SC_H); }
    }
}

__device__ __forceinline__ void conv_fixup(Frame& F, const float* HB, const float* cw, const float* cb, unsigned char* H) {
    const size_t gt = (size_t)F.vcu * (NWAVES * 64) + F.tid, NT = (size_t)F.G * NWAVES * 64;
    constexpr int NCC = DFF / 8;
    for (size_t it = gt; it < (size_t)(M / 256) * NCC; it += NT) { const int pm = (int)(it / NCC), c = (int)(it % NCC) * 8;
        if ((pm & 7) == 0) continue;
        float r[2][4][8];
#pragma unroll
        for (int s = 0; s < 2; ++s)
#pragma unroll
            for (int k = 0; k < 4; ++k) { const float* p = HB + ((size_t)(k < 2 ? pm - 1 : pm) * 4 + (k < 2 ? 2 + k : k - 2)) * (2 * (size_t)DFF) + (size_t)s * DFF + c;
                const f32x4 a = *(const f32x4*)p, b = *(const f32x4*)(p + 4); r[s][k][0] = a.x; r[s][k][1] = a.y; r[s][k][2] = a.z; r[s][k][3] = a.w; r[s][k][4] = b.x; r[s][k][5] = b.y; r[s][k][6] = b.z; r[s][k][7] = b.w; }
#pragma unroll
        for (int q = 0; q < 2; ++q) { float hv[8];
#pragma unroll
            for (int e = 0; e < 8; ++e) { float cv[2];
#pragma unroll
                for (int s = 0; s < 2; ++s) { const size_t ch = (size_t)s * DFF + c + e; cv[s] = cw[ch] * r[s][q][e] + cw[DFF2 + ch] * r[s][q + 1][e] + cw[2 * (size_t)DFF2 + ch] * r[s][q + 2][e] + cb[ch]; }
                hv[e] = cv[0] * cv[1] * __builtin_amdgcn_rcpf(1.f + __builtin_amdgcn_exp2f(-1.4426950408889634f * cv[1])) * SC_H; }
            *(GAS unsigned*)(H + (size_t)(pm * 256 + q) * (DFFP / 2) + c / 2) = pk8_fp4(hv[0], hv[1], hv[2], hv[3], hv[4], hv[5], hv[6], hv[7]); }
    }
    for (size_t it = gt; it < (size_t)M * ((DFFP - DFF) / 8); it += NT) { const int row = (int)(it / ((DFFP - DFF) / 8)), c = DFF + (int)(it % ((DFFP - DFF) / 8)) * 8;
        *(GAS unsigned*)(H + (size_t)row * (DFFP / 2) + c / 2) = 0u; }
}

constexpr int N_PHASES = 12;
struct Args { const float* in[14]; float* out; unsigned char* ws; int ph_lo, ph_hi; };
__global__ void __launch_bounds__(NWAVES * 64, 2) fwd_kernel(Args args) {
    extern __shared__ __attribute__((aligned(16))) unsigned char lds[];
    Frame F;
    F.lds = (LAS unsigned char*)lds;
    F.MISC = (volatile LAS unsigned*)(F.lds + MISC_OFF);
    F.tid = threadIdx.x; F.lane = F.tid & 63; F.wave = __builtin_amdgcn_readfirstlane(F.tid >> 6);
    F.G = gridDim.x; { const int bx = blockIdx.x; F.vcu = (F.G % 8 == 0) ? (bx % 8) * (F.G / 8) + bx / 8 : bx; }
    F.ctl = (gu32*)(args.ws + WS_CTL);
    for (int u = F.tid; u < (LDS_BYTES - LDSCTL_OFF) / 4; u += NWAVES * 64) ((LAS unsigned*)(F.lds + LDSCTL_OFF))[u] = 0u;
    __syncthreads();
    const int lo = args.ph_lo, hi = args.ph_hi;
    const bool multi = true;
    XcdBarrier bar; bar.bar = (unsigned*)(F.ctl + CW_BAR); bar.x = 0; bar.st = nullptr;
    if (multi) bar = xcd_barrier_post((unsigned*)(F.ctl + CW_BAR), F.MISC + 8);
#ifndef PHASE_MASK
#define PHASE_MASK 0xFFF
#endif
#define IN(k) (lo <= (k) && (k) < hi && ((PHASE_MASK >> (k)) & 1))
#ifndef REPEAT_MASK
#define REPEAT_MASK 0
#endif
#define REP(k) for (int rep_ = 0; rep_ < (((REPEAT_MASK >> (k)) & 1) ? 2 : 1); ++rep_)
#define REPBAR(k) do { if (((REPEAT_MASK >> (k)) & 1) && rep_ == 0) xcd_barrier(bar); } while (0)
#define WSP(T, off) ((T*)(args.ws + (off)))
#define INP(i) (args.in[i])
#define SEAM(k) do { if (IN(k) && IN((k) + 1)) xcd_barrier(bar); } while (0)

    if (IN(0)) REP(0) { const P0Args a{INP(0), INP(1), INP(5), INP(8), INP(11), INP(3), INP(4), WSP(f16, WS_WIN), WSP(unsigned char, WS_WV), WSP(unsigned char, WS_WOUT), WSP(unsigned char, WS_WUP), WSP(unsigned char, WS_WDN), WSP(f16, WS_XH), WSP(unsigned char, WS_X1Q), WSP(float, WS_KBAR), WSP(float, WS_SSQ)};     p0_prologue(F, a); VM_WAIT(); __syncthreads(); REPBAR(0); }
    SEAM(0);
    if (IN(1)) {
        { pg8::Gemm g{WSP(const pg8::bf16_t, WS_XH), WSP(const pg8::bf16_t, WS_WIN), M, INA, DM}; pg8::StaticOrder S; S.init(M, INA, F.G, (int)blockIdx.x);
          pg8::EpiF16 E{WSP(pg8::bf16_t, WS_PROJ), IN_PAD, 1.f, 64, 64, C_QI, C_QI, C_QI, nullptr, 0, 0};
          pg8::gemm_phase<pg8::EpiF16, pg8::StaticOrder, true, true, 16, true>(F.lds, g, S, E); }
        if ((int)blockIdx.x >= P0_DEFER_WGS0 && F.G == 256) {
            const P0Args a{INP(0), INP(1), INP(5), INP(8), INP(11), INP(3), INP(4), WSP(f16, WS_WIN), WSP(unsigned char, WS_WV), WSP(unsigned char, WS_WOUT), WSP(unsigned char, WS_WUP), WSP(unsigned char, WS_WDN), WSP(f16, WS_XH), WSP(unsigned char, WS_X1Q), WSP(float, WS_KBAR), WSP(float, WS_SSQ)};
            p0_tile_loop(F, a, P0_TF16 + ((int)blockIdx.x - P0_DEFER_WGS0), P0_T4LO, 256 - P0_DEFER_WGS0);
            VM_WAIT(); __syncthreads(); }
        if (F.G == 256) xcd_barrier(bar);
        { pg8::Gemm g{WSP(const pg8::bf16_t, WS_X1Q), WSP(const pg8::bf16_t, WS_WV), M, INB, DM}; pg8::StaticOrder S; S.init(M, INB, F.G, (int)blockIdx.x);
          pg8::EpiF16 E{WSP(pg8::bf16_t, WS_PROJ), IN_PAD, 1.f / (SC_XQ * SC_WV), 64, 64, 0, 0, 0, WSP(float, WS_KBAR), 8, 16};
          pg8::gemm_phase<pg8::EpiF16, pg8::StaticOrder, false, true, 8, true>(F.lds, g, S, E); }
    }
    SEAM(1);
    if (IN(2)) REP(2) {
        for (int it = F.vcu; it < 256; it += F.G) { const int b = it >> 6, pr = it & 63;
#pragma unroll 1
            for (int k = 0; k < 2; ++k) dsa_index_unit(WSP(const f16, WS_PROJ), WSP(unsigned long long, WS_MW), b, k ? 127 - pr : pr, F.lds, F.tid); }
        for (int it = F.vcu; it < 512; it += F.G) moba_gate_item(WSP(const f16, WS_PROJ), WSP(const float, WS_KBAR), WSP(unsigned char, WS_M8), it, (LAS float*)F.lds, F.tid);
        REPBAR(2);
    }
    SEAM(2);
    if (IN(4)) {
        const P0Args a{INP(0), INP(1), INP(5), INP(8), INP(11), INP(3), INP(4), WSP(f16, WS_WIN), WSP(unsigned char, WS_WV), WSP(unsigned char, WS_WOUT), WSP(unsigned char, WS_WUP), WSP(unsigned char, WS_WDN), WSP(f16, WS_XH), WSP(unsigned char, WS_X1Q), WSP(float, WS_KBAR), WSP(float, WS_SSQ)};
        const bool tiles_first = ((blockIdx.x >> 3) & 1) != 0;
        if (F.G == 256 && tiles_first) { p0_tile_loop(F, a, P0_T4LO + F.vcu, P0_T3LO, F.G); VM_WAIT(); __syncthreads(); }
        attn_phase(F, (char*)lds, WSP(const f16, WS_PROJ), WSP(unsigned char, WS_X1Q), WSP(float, WS_SSQ), INP(3), INP(4), WSP(const unsigned long long, WS_MW), WSP(const unsigned char, WS_M8), INP(2));
        if (F.G == 256 && !tiles_first) { VM_WAIT(); __syncthreads(); p0_tile_loop(F, a, P0_T4LO + F.vcu, P0_T3LO, F.G); }
    }
    SEAM(4);
    if (IN(6)) { pg8::Gemm g{WSP(const pg8::bf16_t, WS_X1Q), WSP(const pg8::bf16_t, WS_WOUT), M, DM, DM}; pg8::StaticOrder S; S.init(M, DM, F.G, (int)blockIdx.x);
        pg8::EpiResHRms E{WSP(pg8::bf16_t, WS_Z), WSP(const pg8::bf16_t, WS_XH), WSP(const float, WS_SSQ), DM, ALPHA, 1.f / (att::SC_Y8 * SC_WO), 1.f / WG_, LN_EPS};
        pg8::gemm_phase<pg8::EpiResHRms, pg8::StaticOrder, true, true, 8, true>(F.lds, g, S, E); }
    SEAM(6);
    if (IN(7)) REP(7) { ln_rows(F, WSP(const f16, WS_Z), INP(6), INP(7), nullptr, WSP(unsigned char, WS_X1Q), WSP(float, WS_STATS));      REPBAR(7); }
    SEAM(7);
    if (IN(8)) { pg8::Gemm g{WSP(const pg8::bf16_t, WS_X1Q), WSP(const pg8::bf16_t, WS_WUP), M, DFF2, DM};   pg8::StaticOrder S; S.init(M, DFF2, F.G, (int)blockIdx.x);
        pg8::EpiConvGate E{WSP(unsigned char, WS_H), DFFP / 2, WSP(float, WS_U), INP(9), INP(10), DFF, 1.f / (SC_X1 * SC_WUP), SC_H, F.lds + 131072};
        pg8::gemm_phase<pg8::EpiConvGate, pg8::StaticOrder, true, true, 4, true>(F.lds, g, S, E);
        if ((int)blockIdx.x >= P0_IDLE8_WGS0 && F.G == 256) {
            const P0Args a{INP(0), INP(1), INP(5), INP(8), INP(11), INP(3), INP(4), WSP(f16, WS_WIN), WSP(unsigned char, WS_WV), WSP(unsigned char, WS_WOUT), WSP(unsigned char, WS_WUP), WSP(unsigned char, WS_WDN), WSP(f16, WS_XH), WSP(unsigned char, WS_X1Q), WSP(float, WS_KBAR), WSP(float, WS_SSQ)};
            p0_tile_loop(F, a, P0_T3LO + ((int)blockIdx.x - P0_IDLE8_WGS0), P0_T2LO, 256 - P0_IDLE8_WGS0); VM_WAIT(); __syncthreads(); } }
    SEAM(8);
    if (IN(9)) { conv_fixup(F, WSP(const float, WS_U), INP(9), INP(10), WSP(unsigned char, WS_H)); }
    SEAM(9);
    if (IN(10)) { pg8::Gemm g{WSP(const pg8::bf16_t, WS_H), WSP(const pg8::bf16_t, WS_WDN), M, DM, DFFP}; pg8::StaticOrder S; S.init(M, DM, F.G, (int)blockIdx.x);
        pg8::EpiLnResH E{WSP(pg8::bf16_t, WS_Z), WSP(const float, WS_STATS), INP(6), INP(7), DM, ALPHA, 1.f / (SC_H * SC_WDN)};
        pg8::gemm_phase<pg8::EpiLnResH, pg8::StaticOrder, true, true, 4, true>(F.lds, g, S, E); }
    SEAM(10);
    if (IN(11)) REP(11) { ln_rows(F, WSP(const f16, WS_Z), INP(12), INP(13), args.out, nullptr, nullptr); REPBAR(11); }
#undef IN
#undef SEAM
}

#ifndef MK_SINGLE
#define MK_SINGLE 1
#endif
extern "C" void kernel_launch(void* const* d_in, const int* in_sizes, int n_in, void* d_out, int out_size, void* d_ws, size_t ws_size, hipStream_t stream) {
    static int grid = 0;
    if (grid == 0) {
        if (n_in != 14 || in_sizes[0] != M * DM || out_size != M * DM || ws_size < WS_END) { fprintf(stderr, "kernel_launch: unexpected shapes (n_in %d, in0 %d, out %d, ws %zu < %zu); nothing launched\n", n_in, n_in > 0 ? in_sizes[0] : -1, out_size, ws_size, (size_t)WS_END); grid = -1; return; }
        int dev = 0, cus = 0, per_cu = 0;
        if (hipGetDevice(&dev) != hipSuccess || hipDeviceGetAttribute(&cus, hipDeviceAttributeMultiprocessorCount, dev) != hipSuccess) { grid = -1; return; }
        if (hipFuncSetAttribute((const void*)fwd_kernel, hipFuncAttributeMaxDynamicSharedMemorySize, LDS_BYTES) != hipSuccess) { fprintf(stderr, "kernel_launch: hipFuncSetAttribute failed\n"); grid = -1; return; }
        if (hipOccupancyMaxActiveBlocksPerMultiprocessor(&per_cu, (const void*)fwd_kernel, NWAVES * 64, LDS_BYTES) != hipSuccess || per_cu < 1)
            fprintf(stderr, "kernel_launch: note: occupancy query reports %d workgroups per CU\n", per_cu);
        (void)hipGetLastError();
        grid = cus;
        if (grid != 256) fprintf(stderr, "kernel_launch: note: %d CUs (built and tuned for 256)\n", grid);
    }
    if (grid < 0) return;
    (void)hipMemsetAsync((char*)d_ws + WS_CTL, 0, CTL_ZERO_BYTES, stream);
    Args a{};
    for (int i = 0; i < 14; ++i) a.in[i] = (const float*)d_in[i];
    a.out = (float*)d_out; a.ws = (unsigned char*)d_ws;
#if MK_SINGLE
    a.ph_lo = 0; a.ph_hi = N_PHASES;
    hipLaunchKernelGGL(fwd_kernel, dim3(grid), dim3(NWAVES * 64), LDS_BYTES, stream, a);
#else
    for (int p = 0; p < N_PHASES; ++p) { a.ph_lo = p; a.ph_hi = p + 1; hipLaunchKernelGGL(fwd_kernel, dim3(grid), dim3(NWAVES * 64), LDS_BYTES, stream, a); }
#endif
}
```
